# Optimizing an MI355X kernel written in HIP

```python
import jax, jax.numpy as jnp
from jax import lax
import numpy as np

D_MODEL = 1024
BATCH = 2
SEQ = 16384
DEPTH = 2
DEC_BATCH = 2
DEC_SEQ = 8192
PAST_LEN = 128

HEAD_DIM = 64
A_Q_HEADS = 8
A_KV_HEADS = 2
B_Q_HEADS = 8
B_KV_HEADS = 2
A_WIDTH = A_Q_HEADS * HEAD_DIM
B_WIDTH = B_Q_HEADS * HEAD_DIM
MIX_WIDTH = A_WIDTH + B_WIDTH
A_KV_WIDTH = A_KV_HEADS * HEAD_DIM
B_KV_WIDTH = B_KV_HEADS * HEAD_DIM
IN_WIDTH = A_WIDTH + 2 * A_KV_WIDTH + B_WIDTH + 2 * B_KV_WIDTH
D_FF = 2816
GRID_W = 64
ROPE_THETA = 10000.0
WINDOW = 128
Q_BLOCK = 128
NORM_EPS = 1e-6
FFN_RESID = 0.5
ATTN_SCALE = HEAD_DIM ** -0.5

kernel_name = "hybrid_axial_window_macaron_encoder"


def rms_norm(x, g):
    xf = x.astype(jnp.float32)
    y = xf * lax.rsqrt(jnp.mean(xf * xf, axis=-1, keepdims=True) + NORM_EPS)
    return (y * g.astype(jnp.float32)).astype(x.dtype)


def swiglu(x, w_gate, w_up, w_down):
    return (jax.nn.silu(x @ w_gate) * (x @ w_up)) @ w_down


def axial_rope_tables(seq_len):
    n_rows = seq_len // GRID_W
    row = jnp.repeat(jnp.arange(n_rows, dtype=jnp.float32), GRID_W)
    col = jnp.tile(jnp.arange(GRID_W, dtype=jnp.float32), n_rows)
    n_freq = HEAD_DIM // 4
    inv_freq = ROPE_THETA ** (-jnp.arange(n_freq, dtype=jnp.float32) / n_freq)
    ang = jnp.concatenate([row[:, None] * inv_freq[None, :], col[:, None] * inv_freq[None, :]], axis=-1)
    return jnp.cos(ang), jnp.sin(ang)


def apply_rope(x, cos, sin):
    b, s, h, d = x.shape
    xf = x.astype(jnp.float32).reshape(b, s, h, d // 2, 2)
    x0, x1 = xf[..., 0], xf[..., 1]
    c = cos[None, :, None, :]
    sn = sin[None, :, None, :]
    out = jnp.stack([x0 * c - x1 * sn, x0 * sn + x1 * c], axis=-1)
    return out.reshape(b, s, h, d).astype(x.dtype)


def alibi_slopes():
    return 2.0 ** (-8.0 * jnp.arange(1, B_Q_HEADS + 1, dtype=jnp.float32) / B_Q_HEADS)


def global_attention(q, k, v):
    b, s, hq, d = q.shape
    hkv = k.shape[2]
    g = hq // hkv
    nblk = s // Q_BLOCK
    qb = (q * ATTN_SCALE).reshape(b, nblk, Q_BLOCK, hkv, g, d).transpose(1, 0, 2, 3, 4, 5)

    def one_block(qi):
        sc = jnp.einsum('bqhgd,bshd->bhgqs', qi, k, preferred_element_type=jnp.float32)
        p = jax.nn.softmax(sc, axis=-1)
        return jnp.einsum('bhgqs,bshd->bqhgd', p.astype(v.dtype), v)

    o = lax.map(one_block, qb)
    return o.transpose(1, 0, 2, 3, 4, 5).reshape(b, s, hq * d)


def window_attention(q, k, v, sink, slopes):
    b, s, hq, d = q.shape
    hkv = k.shape[2]
    g = hq // hkv
    nblk = s // Q_BLOCK
    pad = ((0, 0), (WINDOW, WINDOW), (0, 0), (0, 0))
    kp = jnp.pad(k, pad).reshape(b, nblk + 2, Q_BLOCK, hkv, d)
    vp = jnp.pad(v, pad).reshape(b, nblk + 2, Q_BLOCK, hkv, d)
    kband = jnp.concatenate([kp[:, :-2], kp[:, 1:-1], kp[:, 2:]], axis=2)
    vband = jnp.concatenate([vp[:, :-2], vp[:, 1:-1], vp[:, 2:]], axis=2)
    qb = (q * ATTN_SCALE).reshape(b, nblk, Q_BLOCK, hkv, g, d)
    sc = jnp.einsum('bnqhgd,bnkhd->bnhgqk', qb, kband, preferred_element_type=jnp.float32)
    blk = jnp.arange(nblk)[:, None] * Q_BLOCK
    qpos = blk + jnp.arange(Q_BLOCK)[None, :]
    kpos = blk - WINDOW + jnp.arange(3 * Q_BLOCK)[None, :]
    dist = jnp.abs(qpos[:, :, None] - kpos[:, None, :])
    valid = (dist <= WINDOW) & (kpos >= 0)[:, None, :] & (kpos < s)[:, None, :]
    m_h = slopes.reshape(hkv, g)[None, None, :, :, None, None]
    sc = sc - m_h * dist.astype(jnp.float32)[None, :, None, None, :, :]
    sc = jnp.where(valid[None, :, None, None, :, :], sc, -jnp.inf)
    sink_l = sink.astype(jnp.float32).reshape(hkv, g)[None, None, :, :, None, None]
    mx = jnp.maximum(jnp.max(sc, axis=-1, keepdims=True), sink_l)
    e = jnp.exp(sc - mx)
    p = e / (jnp.sum(e, axis=-1, keepdims=True) + jnp.exp(sink_l - mx))
    o = jnp.einsum('bnhgqk,bnkhd->bnqhgd', p.astype(v.dtype), vband)
    return o.reshape(b, s, hq * d)


def token_mixer(h, w_in, a_q_norm, a_k_norm, b_sink, a_out_norm, b_out_norm, w_out, cos, sin, slopes):
    b, s, _ = h.shape
    proj = h @ w_in
    offs = np.cumsum([A_WIDTH, A_KV_WIDTH, A_KV_WIDTH, B_WIDTH, B_KV_WIDTH]).tolist()
    qa, ka, va, qb, kb, vb = jnp.split(proj, offs, axis=-1)
    qa = qa.reshape(b, s, A_Q_HEADS, HEAD_DIM)
    ka = ka.reshape(b, s, A_KV_HEADS, HEAD_DIM)
    va = va.reshape(b, s, A_KV_HEADS, HEAD_DIM)
    qa = apply_rope(rms_norm(qa, a_q_norm), cos, sin)
    ka = apply_rope(rms_norm(ka, a_k_norm), cos, sin)
    oa = global_attention(qa, ka, va)
    qb = qb.reshape(b, s, B_Q_HEADS, HEAD_DIM)
    kb = kb.reshape(b, s, B_KV_HEADS, HEAD_DIM)
    vb = vb.reshape(b, s, B_KV_HEADS, HEAD_DIM)
    ob = window_attention(qb, kb, vb, b_sink, slopes)
    merged = jnp.concatenate([rms_norm(oa, a_out_norm), rms_norm(ob, b_out_norm)], axis=-1)
    return merged @ w_out


def encoder_trunk(x, ffn1_pre, ffn1_post, ffn1_w_gate, ffn1_w_up, ffn1_w_down,
                  mix_pre, mix_post, w_in, a_q_norm, a_k_norm, b_sink, a_out_norm, b_out_norm, w_out,
                  ffn2_pre, ffn2_post, ffn2_w_gate, ffn2_w_up, ffn2_w_down):
    seq_len = x.shape[1]
    cos, sin = axial_rope_tables(seq_len)
    slopes = alibi_slopes()
    for l in range(DEPTH):
        h = swiglu(rms_norm(x, ffn1_pre[l]), ffn1_w_gate[l], ffn1_w_up[l], ffn1_w_down[l])
        x = x + FFN_RESID * rms_norm(h, ffn1_post[l])
        h = token_mixer(rms_norm(x, mix_pre[l]), w_in[l], a_q_norm[l], a_k_norm[l], b_sink[l],
                        a_out_norm[l], b_out_norm[l], w_out[l], cos, sin, slopes)
        x = x + rms_norm(h, mix_post[l])
        h = swiglu(rms_norm(x, ffn2_pre[l]), ffn2_w_gate[l], ffn2_w_up[l], ffn2_w_down[l])
        x = x + FFN_RESID * rms_norm(h, ffn2_post[l])
    return x


def setup_inputs(seed: int = 0) -> dict:
    key = jax.random.key(seed)
    ks = jax.random.split(key, 24)
    f32 = jnp.float32

    def nrm(k, shape, scale):
        return jax.random.normal(k, shape, f32) * scale

    def gain(k, n):
        return jnp.ones((DEPTH, n), f32) + 0.05 * jax.random.normal(k, (DEPTH, n), f32)

    return {
        "x_prompt": jax.random.normal(ks[0], (BATCH, SEQ, D_MODEL), f32),
        "x_sample": jax.random.normal(ks[1], (DEC_BATCH, DEC_SEQ, D_MODEL), f32),
        "ffn1_pre": gain(ks[2], D_MODEL),
        "ffn1_post": gain(ks[3], D_MODEL),
        "ffn1_w_gate": nrm(ks[4], (DEPTH, D_MODEL, D_FF), D_MODEL ** -0.5),
        "ffn1_w_up": nrm(ks[5], (DEPTH, D_MODEL, D_FF), D_MODEL ** -0.5),
        "ffn1_w_down": nrm(ks[6], (DEPTH, D_FF, D_MODEL), D_FF ** -0.5),
        "mix_pre": gain(ks[7], D_MODEL),
        "mix_post": gain(ks[8], D_MODEL),
        "w_in": nrm(ks[9], (DEPTH, D_MODEL, IN_WIDTH), D_MODEL ** -0.5),
        "a_q_norm": gain(ks[10], HEAD_DIM),
        "a_k_norm": gain(ks[11], HEAD_DIM),
        "b_sink": nrm(ks[12], (DEPTH, B_Q_HEADS), 0.5),
        "a_out_norm": gain(ks[13], A_WIDTH),
        "b_out_norm": gain(ks[14], B_WIDTH),
        "w_out": nrm(ks[15], (DEPTH, MIX_WIDTH, D_MODEL), MIX_WIDTH ** -0.5),
        "ffn2_pre": gain(ks[16], D_MODEL),
        "ffn2_post": gain(ks[17], D_MODEL),
        "ffn2_w_gate": nrm(ks[18], (DEPTH, D_MODEL, D_FF), D_MODEL ** -0.5),
        "ffn2_w_up": nrm(ks[19], (DEPTH, D_MODEL, D_FF), D_MODEL ** -0.5),
        "ffn2_w_down": nrm(ks[20], (DEPTH, D_FF, D_MODEL), D_FF ** -0.5),
    }


def reference(x_prompt, x_sample, ffn1_pre, ffn1_post, ffn1_w_gate, ffn1_w_up, ffn1_w_down,
              mix_pre, mix_post, w_in, a_q_norm, a_k_norm, b_sink, a_out_norm, b_out_norm, w_out,
              ffn2_pre, ffn2_post, ffn2_w_gate, ffn2_w_up, ffn2_w_down):
    y_prompt = encoder_trunk(x_prompt, ffn1_pre, ffn1_post, ffn1_w_gate, ffn1_w_up, ffn1_w_down,
                             mix_pre, mix_post, w_in, a_q_norm, a_k_norm, b_sink, a_out_norm, b_out_norm, w_out,
                             ffn2_pre, ffn2_post, ffn2_w_gate, ffn2_w_up, ffn2_w_down)
    y_sample = encoder_trunk(x_sample, ffn1_pre, ffn1_post, ffn1_w_gate, ffn1_w_up, ffn1_w_down,
                             mix_pre, mix_post, w_in, a_q_norm, a_k_norm, b_sink, a_out_norm, b_out_norm, w_out,
                             ffn2_pre, ffn2_post, ffn2_w_gate, ffn2_w_up, ffn2_w_down)
    return (y_prompt, y_sample)
```

```cpp
#include <hip/hip_runtime.h>
#include <cstdio>
#include <cstdint>
#ifndef PG8_WGM
#define PG8_WGM 8
#endif
namespace pg8 {
#define PG8_LAS __attribute__((address_space(3)))
typedef unsigned short bf16_t;
typedef short bf16x8 __attribute__((ext_vector_type(8)));
typedef float f32x4 __attribute__((ext_vector_type(4)));
typedef unsigned u32x4 __attribute__((ext_vector_type(4)));
constexpr int BM = 256, BK = 64, HALF = 128, HTB = HALF * BK * 2  , STAGE_BYTES = 8 * HTB, NXCD = 8, WGM = PG8_WGM;

__host__ __device__ __forceinline__ int lds_byte(int r, int c) { const int st = (r >> 4) * 2 + (c >> 5), rr = r & 15, cc = c & 31, ob = rr * 64 + cc * 2; return st * 1024 + (ob ^ (((ob >> 9) & 1) << 5)); }
__host__ __device__ __forceinline__ void stage_rc(int b, int& R, int& C) { const int st = b / 1024, sb = b % 1024, swz = sb ^ (((sb >> 9) & 1) << 5); R = (st >> 1) * 16 + swz / 64; C = (st & 1) * 32 + (swz % 64) / 2; }
__host__ __device__ __forceinline__ int perm32(int rho) { const int n = rho >> 4, i = rho & 15; return 8 * (i >> 2) + 4 * n + (i & 3); }

struct Unit { int pm, pn; };
struct Gemm { const bf16_t* A; const bf16_t* Bt; int M, N, K; };

struct StaticOrder {
    int nM, nN, nwg, G, c, nfull, rev;
    __host__ __device__ void init(int M, int N, int G_, int c_, bool half_tail = false, bool rev_ = false) { nM = M / BM; nN = N / BM; nwg = nM * nN; G = G_; c = c_; nfull = nwg; rev = rev_ ? 1 : 0;
        if (half_tail) { const int f = (nwg / G) * G; if ((G & 1) == 0 && (nwg - f) * 2 == G) nfull = f; } }
    __host__ __device__ void map(int L, Unit& u) const {
        int wgid = L; { const int q = nwg / NXCD, r = nwg % NXCD, xcd = wgid % NXCD, off = wgid / NXCD; wgid = (xcd < r ? xcd * (q + 1) : r * (q + 1) + (xcd - r) * q) + off; }
        const int nig = WGM * nN, gid = wgid / nig, fm = gid * WGM, gsz = (nM - fm) < WGM ? (nM - fm) : WGM;
        u.pm = fm + ((wgid % nig) % gsz); u.pn = (wgid % nig) / gsz; if (rev) u.pm = nM - 1 - u.pm; }
    __host__ __device__ bool half_unit(Unit& u, int& h) const { if (nfull == nwg) return false; map(nfull + (c >> 1), u); h = c & 1; return true; }
    __host__ __device__ bool next(int i, Unit& u) const {
        const long L = (long)i * G + c; if (L >= nfull) return false;
        map((int)L, u); return true;
    }
    __device__ __forceinline__ void a_ready(const Unit&) const {}
    __device__ __forceinline__ void done(const Unit&) const {}
};

__device__ __forceinline__ unsigned cvt_pk_bf16(float lo, float hi) { unsigned r; asm volatile("v_cvt_pk_bf16_f32 %0, %1, %2" : "=v"(r) : "v"(lo), "v"(hi)); return r; }
__device__ __forceinline__ float silu_mul(float g, float u, float c1, float c2) { const float e = __builtin_amdgcn_exp2f(g * c1); return (g * u) * (c2 * __builtin_amdgcn_rcpf(1.0f + e)); }
struct EpiSwiGLU {
    static constexpr bool PERM = true, AFTER_DRAIN = false, MIDSCALE = false, PREFETCH = false, HALF_TAIL = false;
    __device__ __forceinline__ void half(const f32x4 (&acc)[2][2][4][2], const Unit& u, int hh, int wr, int wc, int fr, int fq) const {
        unsigned lrow = (unsigned)(hh * HALF + wr * 64 + fr); asm volatile("" : "+v"(lrow)); const float* rb = rsx + u.pm * BM;
        bf16_t* obase = O + (size_t)u.pm * BM * ldc + u.pn * HALF + wc * 32 + 8 * fq;
#pragma unroll
        for (int m = 0; m < 4; ++m) { const unsigned lr = lrow + (unsigned)(m * 16); const float rs = rb[lr], c1 = rs * -1.4426950408889634f, c2 = rs * rs;
            const f32x4 g0 = acc[0][0][m][0], g1 = acc[0][0][m][1], u0 = acc[0][1][m][0], u1 = acc[0][1][m][1];
            u32x4 w; w.x = cvt_pk_bf16(silu_mul(g0[0], u0[0], c1, c2), silu_mul(g0[1], u0[1], c1, c2)); w.y = cvt_pk_bf16(silu_mul(g0[2], u0[2], c1, c2), silu_mul(g0[3], u0[3], c1, c2));
            w.z = cvt_pk_bf16(silu_mul(g1[0], u1[0], c1, c2), silu_mul(g1[1], u1[1], c1, c2)); w.w = cvt_pk_bf16(silu_mul(g1[2], u1[2], c1, c2), silu_mul(g1[3], u1[3], c1, c2));
            *(u32x4*)(obase + (size_t)lr * ldc) = w; }
    }
    bf16_t* O; int ldc; const float* rsx;
    __device__ __forceinline__ void prefetch(const Unit& u, int wr, int fr, float (&rsv)[2][4]) const {
        unsigned lrow = (unsigned)(wr * 64 + fr); asm volatile("" : "+v"(lrow)); const float* rb = rsx + u.pm * BM;
#pragma unroll
        for (int ai = 0; ai < 2; ++ai)
#pragma unroll
            for (int m = 0; m < 4; ++m) rsv[ai][m] = rb[lrow + (unsigned)(ai * HALF + m * 16)];
    }
    __device__ __forceinline__ void operator()(const f32x4 (&acc)[2][2][4][2], const Unit& u, int wr, int wc, int fr, int fq) const {
        const int row0 = u.pm * BM + wr * 64 + fr; const int col0 = u.pn * HALF + wc * 32 + 8 * fq;
        float rsv[2][4]; prefetch(u, wr, fr, rsv);
#pragma unroll
        for (int ai = 0; ai < 2; ++ai)
#pragma unroll
            for (int m = 0; m < 4; ++m) { bf16_t* rowp = O + (size_t)(row0 + ai * HALF + m * 16) * ldc + col0;
                const float rs = rsv[ai][m], c1 = rs * -1.4426950408889634f, c2 = rs * rs; const f32x4 g0 = acc[ai][0][m][0], g1 = acc[ai][0][m][1], u0 = acc[ai][1][m][0], u1 = acc[ai][1][m][1];
                u32x4 w; w.x = cvt_pk_bf16(silu_mul(g0[0], u0[0], c1, c2), silu_mul(g0[1], u0[1], c1, c2)); w.y = cvt_pk_bf16(silu_mul(g0[2], u0[2], c1, c2), silu_mul(g0[3], u0[3], c1, c2));
                w.z = cvt_pk_bf16(silu_mul(g1[0], u1[0], c1, c2), silu_mul(g1[1], u1[1], c1, c2)); w.w = cvt_pk_bf16(silu_mul(g1[2], u1[2], c1, c2), silu_mul(g1[3], u1[3], c1, c2));
                *(u32x4*)rowp = w; }
    }
};
struct EpiPlain {
    static constexpr bool PERM = true, AFTER_DRAIN = false, MIDSCALE = false, PREFETCH = false, HALF_TAIL = false;
    bf16_t* O; int ldc; int sc_lo, sc_hi; float scv;
    __device__ __forceinline__ void operator()(const f32x4 (&acc)[2][2][4][2], const Unit& u, int wr, int wc, int fr, int fq) const {
        const int row0 = u.pm * BM + wr * 64 + fr; const int col0 = u.pn * BM + wc * 32 + 8 * fq;
        const float sc = (u.pn >= sc_lo && u.pn < sc_hi) ? scv : 1.0f;
#pragma unroll
        for (int ai = 0; ai < 2; ++ai)
#pragma unroll
            for (int m = 0; m < 4; ++m) { bf16_t* rowp = O + (size_t)(row0 + ai * HALF + m * 16) * ldc + col0;
#pragma unroll
                for (int bj = 0; bj < 2; ++bj) { const f32x4 v0 = acc[ai][bj][m][0] * sc, v1 = acc[ai][bj][m][1] * sc;
                    u32x4 w; w.x = cvt_pk_bf16(v0[0], v0[1]); w.y = cvt_pk_bf16(v0[2], v0[3]); w.z = cvt_pk_bf16(v1[0], v1[1]); w.w = cvt_pk_bf16(v1[2], v1[3]);
                    *(u32x4*)(rowp + bj * HALF) = w; } }
    }
};


struct EpiWin {
    static constexpr bool PERM = true, AFTER_DRAIN = false, MIDSCALE = false, PREFETCH = false, HALF_TAIL = false;
    bf16_t* O; const float* rsx; const float* gq; const float* gk; float qscale;
    __device__ __forceinline__ void operator()(const f32x4 (&acc)[2][2][4][2], const Unit& u, int wr, int wc, int fr, int fq) const {
        const int hc = u.pn * BM + wc * 64;
        unsigned lrow = (unsigned)(wr * 64 + fr); asm volatile("" : "+v"(lrow));
        unsigned loff = lrow * 1536u + (unsigned)(wc * 64 + 8 * fq);
        bf16_t* obase = O + (size_t)u.pm * BM * 1536 + u.pn * BM;
        const float* rbase = rsx + u.pm * BM; const int trow0 = u.pm * BM;
        if (hc < 640) {
            const float* gp = (hc < 512) ? gq : gk; const float osc = (hc < 512) ? qscale : 1.0f;
            f32x4 gg[2][2]; float invf[2][2];
#pragma unroll
            for (int bj = 0; bj < 2; ++bj)
#pragma unroll
                for (int n = 0; n < 2; ++n) gg[bj][n] = *(const f32x4*)(gp + 32 * bj + 8 * fq + 4 * n);
#pragma unroll
            for (int n = 0; n < 2; ++n)
#pragma unroll
                for (int jj = 0; jj < 2; ++jj) invf[n][jj] = __builtin_amdgcn_exp2f((float)(4 * fq + 2 * n + jj) * -0.83048202372184058696f) * 0.15915494309189533577f;
#pragma unroll
            for (int ai = 0; ai < 2; ++ai)
#pragma unroll
                for (int m = 0; m < 4; ++m) {
                    const unsigned lr = lrow + (unsigned)(ai * HALF + m * 16); const int row = trow0 + (int)lr; const int t = (row < 32768) ? (row & 16383) : (row & 8191);
                    const float rs = rbase[lr]; float pos[2]; pos[0] = (float)(t >> 6); pos[1] = (float)(t & 63);
                    f32x4 v[2][2]; float ss = 0.f;
#pragma unroll
                    for (int bj = 0; bj < 2; ++bj)
#pragma unroll
                        for (int n = 0; n < 2; ++n) { v[bj][n] = acc[ai][bj][m][n] * rs; ss += (v[bj][n][0] * v[bj][n][0] + v[bj][n][1] * v[bj][n][1]) + (v[bj][n][2] * v[bj][n][2] + v[bj][n][3] * v[bj][n][3]); }
                    ss += __shfl_xor(ss, 16); ss += __shfl_xor(ss, 32);
                    const float rstd = __builtin_amdgcn_rsqf(ss * (1.0f / 64.0f) + 1e-6f);
#pragma unroll
                    for (int bj = 0; bj < 2; ++bj) { float o[8];
#pragma unroll
                        for (int n = 0; n < 2; ++n) { const f32x4 x = v[bj][n] * rstd * gg[bj][n];
#pragma unroll
                            for (int jj = 0; jj < 2; ++jj) { float rev = pos[bj] * invf[n][jj]; rev = rev - __builtin_floorf(rev);
                                const float sn = __builtin_amdgcn_sinf(rev), cs = __builtin_amdgcn_cosf(rev); const float x0 = x[2 * jj], x1 = x[2 * jj + 1];
                                o[4 * n + 2 * jj] = (x0 * cs - x1 * sn) * osc; o[4 * n + 2 * jj + 1] = (x0 * sn + x1 * cs) * osc; } }
                        u32x4 w; w.x = cvt_pk_bf16(o[0], o[1]); w.y = cvt_pk_bf16(o[2], o[3]); w.z = cvt_pk_bf16(o[4], o[5]); w.w = cvt_pk_bf16(o[6], o[7]);
                        *(u32x4*)(obase + (loff + (unsigned)((ai * HALF + m * 16) * 1536 + 32 * bj))) = w; }
                    asm volatile("" ::: "memory"); __builtin_amdgcn_sched_barrier(0);
                }
        } else {
            const float sc = (hc >= 768 && hc < 1280) ? qscale : 1.0f;
#pragma unroll
            for (int ai = 0; ai < 2; ++ai)
#pragma unroll
                for (int m = 0; m < 4; ++m) { const unsigned lr = lrow + (unsigned)(ai * HALF + m * 16); const float rs = rbase[lr] * sc;
#pragma unroll
                    for (int bj = 0; bj < 2; ++bj) { const f32x4 v0 = acc[ai][bj][m][0] * rs, v1 = acc[ai][bj][m][1] * rs;
                        u32x4 w; w.x = cvt_pk_bf16(v0[0], v0[1]); w.y = cvt_pk_bf16(v0[2], v0[3]); w.z = cvt_pk_bf16(v1[0], v1[1]); w.w = cvt_pk_bf16(v1[2], v1[3]);
                        *(u32x4*)(obase + (loff + (unsigned)((ai * HALF + m * 16) * 1536 + 32 * bj))) = w; } }
        }
    }
};


struct EpiOutNorm {
    static constexpr bool PERM = true, AFTER_DRAIN = false, MIDSCALE = true, PREFETCH = false, HALF_TAIL = false;
    bf16_t* O; int ldc; const float* ssq;
    __device__ __forceinline__ void mid(f32x4 (&acc)[2][2][4][2], const Unit& u, int wr, int fr, float (&rbv)[2][4]) const {
        unsigned lrow = (unsigned)(wr * 64 + fr); asm volatile("" : "+v"(lrow));
        const float* sb = ssq + (size_t)u.pm * BM * 16;
#pragma unroll
        for (int ai = 0; ai < 2; ++ai)
#pragma unroll
            for (int m = 0; m < 4; ++m) { const f32x4* p = (const f32x4*)(sb + (lrow + (unsigned)(ai * HALF + m * 16)) * 16u);
                const f32x4 a0 = p[0], a1 = p[1], b0 = p[2], b1 = p[3];
                const float sa = ((a0[0] + a0[1]) + (a0[2] + a0[3])) + ((a1[0] + a1[1]) + (a1[2] + a1[3])), sb2 = ((b0[0] + b0[1]) + (b0[2] + b0[3])) + ((b1[0] + b1[1]) + (b1[2] + b1[3]));
                const float ra = __builtin_amdgcn_rsqf(sa * (1.0f / 512.0f) + 1e-6f), rb = __builtin_amdgcn_rsqf(sb2 * (1.0f / 512.0f) + 1e-6f);
                rbv[ai][m] = rb; const float ratio = ra * __builtin_amdgcn_rcpf(rb);
#pragma unroll
                for (int bj = 0; bj < 2; ++bj)
#pragma unroll
                    for (int n = 0; n < 2; ++n) acc[ai][bj][m][n] = acc[ai][bj][m][n] * ratio; }
    }
    __device__ __forceinline__ void operator()(const f32x4 (&acc)[2][2][4][2], const Unit& u, int wr, int wc, int fr, int fq, const float (&rbv)[2][4]) const {
        const int row0 = u.pm * BM + wr * 64 + fr; const int col0 = u.pn * BM + wc * 32 + 8 * fq;
#pragma unroll
        for (int ai = 0; ai < 2; ++ai)
#pragma unroll
            for (int m = 0; m < 4; ++m) { bf16_t* rowp = O + (size_t)(row0 + ai * HALF + m * 16) * ldc + col0; const float sc = rbv[ai][m];
#pragma unroll
                for (int bj = 0; bj < 2; ++bj) { const f32x4 v0 = acc[ai][bj][m][0] * sc, v1 = acc[ai][bj][m][1] * sc;
                    u32x4 w; w.x = cvt_pk_bf16(v0[0], v0[1]); w.y = cvt_pk_bf16(v0[2], v0[3]); w.z = cvt_pk_bf16(v1[0], v1[1]); w.w = cvt_pk_bf16(v1[2], v1[3]);
                    *(u32x4*)(rowp + bj * HALF) = w; } }
    }
};

template <class Epi, class Sched, bool ALIGN_EPI = false, bool SP2 = false>
__device__ __forceinline__ void gemm_phase(PG8_LAS unsigned char* lds, const Gemm g, const Sched& S, const Epi& E, int tid_in) {
    int tid_ = tid_in; asm volatile("" : "+v"(tid_)); const int tid = tid_, wid = __builtin_amdgcn_readfirstlane(tid >> 6), lane = tid & 63, wr = wid >> 2, wc = wid & 3, fr = lane & 15, fq = lane >> 4;
    const int K = g.K, nt = K / BK;
    unsigned voffA[2], voffB[2];
#pragma unroll
    for (int i = 0; i < 2; ++i) { int R, C; stage_rc(tid * 16 + i * 8192, R, C); const int Rb = Epi::PERM ? ((R & ~31) + perm32(R & 31)) : R;
        voffA[i] = (unsigned)(R * K + C) * 2u; voffB[i] = (unsigned)(Rb * K + C) * 2u; }
    const size_t kstep = (size_t)(BK * 2);
    const size_t hstep = (size_t)HALF * K * 2;
    const size_t tstep = 2 * hstep;
    const unsigned ldsw = (unsigned)wid * 1024u;
    const int aoff = lds_byte(wr * 64 + fr, fq * 8), boff = lds_byte(wc * 32 + fr, fq * 8);
#define PG8_SA(b, h) (((b) * 2 + (h)) * HTB)
#define PG8_SB(b, h) ((4 + (b) * 2 + (h)) * HTB)
#define PG8_STAGE(bufoff, gbase, voff) do { _Pragma("unroll") for (int _i = 0; _i < 2; ++_i) \
        __builtin_amdgcn_global_load_lds((const unsigned*)((const char*)(gbase) + (voff)[_i]), (PG8_LAS unsigned*)(lds + (bufoff) + ldsw + _i * 8192), 16, 0, 0); } while (0)
#define PG8_LDA(dst, b, h) do { _Pragma("unroll") for (int m = 0; m < 4; ++m) _Pragma("unroll") for (int k = 0; k < 2; ++k) dst[m][k] = *(const PG8_LAS bf16x8*)(lds + PG8_SA(b, h) + aoff + m * 2048 + k * 1024); } while (0)
#define PG8_LDB(dst, b, h) do { _Pragma("unroll") for (int n = 0; n < 2; ++n) _Pragma("unroll") for (int k = 0; k < 2; ++k) dst[n][k] = *(const PG8_LAS bf16x8*)(lds + PG8_SB(b, h) + boff + n * 2048 + k * 1024); } while (0)
#define PG8_MMA(ai, bj, At, Bt) do { __builtin_amdgcn_s_setprio(1); _Pragma("unroll") for (int m = 0; m < 4; ++m) _Pragma("unroll") for (int n = 0; n < 2; ++n) _Pragma("unroll") for (int k = 0; k < 2; ++k) \
        acc[ai][bj][m][n] = __builtin_amdgcn_mfma_f32_16x16x32_bf16(Bt[n][k], At[m][k], acc[ai][bj][m][n], 0, 0, 0); __builtin_amdgcn_s_setprio(0); } while (0)
#define PG8_WAIT_V(n) asm volatile("s_waitcnt vmcnt(" #n ")" ::: "memory")
#define PG8_WAIT_L(n) asm volatile("s_waitcnt lgkmcnt(" #n ")" ::: "memory")
#define PG8_BAR __builtin_amdgcn_s_barrier()
#define PG8_SCHED __builtin_amdgcn_sched_barrier(0)
    Unit cur, nxt; int ui = 0;
    if (!S.next(0, cur)) return;
    f32x4 acc[2][2][4][2]; float midst[2][4];
#pragma unroll
    for (int a = 0; a < 2; ++a)
#pragma unroll
        for (int b = 0; b < 2; ++b)
#pragma unroll
            for (int m = 0; m < 4; ++m)
#pragma unroll
                for (int n = 0; n < 2; ++n) acc[a][b][m][n] = (f32x4){0.f, 0.f, 0.f, 0.f};
    bf16x8 At[4][2], B0[2][2], B1[2][2];
    const char* cA = (const char*)g.A + (size_t)cur.pm * tstep; const char* cB = (const char*)g.Bt + (size_t)cur.pn * tstep;
    S.a_ready(cur);
    if constexpr (SP2) {
        PG8_STAGE(PG8_SB(0, 0), cB, voffB); PG8_STAGE(PG8_SB(0, 1), cB + hstep, voffB); PG8_STAGE(PG8_SA(0, 0), cA, voffA); PG8_STAGE(PG8_SA(0, 1), cA + hstep, voffA);
        if (wr == 1) PG8_BAR;
        PG8_WAIT_V(2); PG8_BAR;
        PG8_STAGE(PG8_SB(1, 0), cB + kstep, voffB); PG8_STAGE(PG8_SA(1, 0), cA + kstep, voffA); PG8_STAGE(PG8_SB(1, 1), cB + hstep + kstep, voffB);
        PG8_WAIT_V(6); PG8_BAR;
    } else {
        PG8_STAGE(PG8_SB(0, 0), cB, voffB); PG8_STAGE(PG8_SA(0, 0), cA, voffA); PG8_STAGE(PG8_SB(0, 1), cB + hstep, voffB); PG8_STAGE(PG8_SA(0, 1), cA + hstep, voffA);
        if (wr == 1) PG8_BAR;
        PG8_WAIT_V(4); PG8_BAR;
        PG8_STAGE(PG8_SB(1, 0), cB + kstep, voffB); PG8_STAGE(PG8_SA(1, 0), cA + kstep, voffA); PG8_STAGE(PG8_SB(1, 1), cB + hstep + kstep, voffB);
        PG8_WAIT_V(6); PG8_BAR;
    }
    for (;;) {
        const bool has_next = S.next(ui + 1, nxt);
        const char* nA = has_next ? (const char*)g.A + (size_t)nxt.pm * tstep : cA; const char* nB = has_next ? (const char*)g.Bt + (size_t)nxt.pn * tstep : cB;
        for (int t = 0; t < nt; t += 2) {
            if constexpr (Epi::MIDSCALE) { if (t == (nt >> 1)) E.mid(acc, cur, wr, fr, midst); }
            if constexpr (Epi::PREFETCH) { if (t == nt - 2) E.prefetch(cur, wr, fr, midst); }
            const bool last = (t == nt - 2);
            const char* a1 = cA + (size_t)(t + 1) * kstep;
            const char* a2 = last ? nA : cA + (size_t)(t + 2) * kstep; const char* b2 = last ? nB : cB + (size_t)(t + 2) * kstep;
            const char* a3 = a2 + kstep; const char* b3 = b2 + kstep;
            if (last && has_next) S.a_ready(nxt);
            if constexpr (SP2) {
            PG8_LDB(B0, 0, 0); PG8_LDB(B1, 0, 1); PG8_SCHED; PG8_LDA(At, 0, 0); PG8_STAGE(PG8_SA(1, 1), a1 + hstep, voffA);
            PG8_WAIT_V(8); PG8_WAIT_L(0); PG8_BAR; PG8_MMA(0, 0, At, B0); PG8_MMA(0, 1, At, B1); PG8_BAR; PG8_SCHED;
            PG8_LDA(At, 0, 1); PG8_STAGE(PG8_SB(0, 0), b2, voffB); PG8_STAGE(PG8_SB(0, 1), b2 + hstep, voffB); PG8_STAGE(PG8_SA(0, 0), a2, voffA);
            PG8_WAIT_V(8); PG8_WAIT_L(0); PG8_BAR; PG8_MMA(1, 0, At, B0); PG8_MMA(1, 1, At, B1); PG8_BAR; PG8_SCHED;
            PG8_LDB(B0, 1, 0); PG8_LDB(B1, 1, 1); PG8_SCHED; PG8_LDA(At, 1, 0); PG8_STAGE(PG8_SA(0, 1), a2 + hstep, voffA);
            PG8_WAIT_V(8); PG8_WAIT_L(0); PG8_BAR; PG8_MMA(0, 0, At, B0); PG8_MMA(0, 1, At, B1); PG8_BAR; PG8_SCHED;
            PG8_LDA(At, 1, 1); PG8_STAGE(PG8_SB(1, 0), b3, voffB); PG8_STAGE(PG8_SB(1, 1), b3 + hstep, voffB); PG8_STAGE(PG8_SA(1, 0), a3, voffA);
            PG8_WAIT_V(8); PG8_WAIT_L(0); PG8_BAR; PG8_MMA(1, 0, At, B0); PG8_MMA(1, 1, At, B1); PG8_BAR; PG8_SCHED;
            } else {
            PG8_LDB(B0, 0, 0); PG8_SCHED; PG8_LDA(At, 0, 0); PG8_STAGE(PG8_SA(1, 1), a1 + hstep, voffA);
            PG8_WAIT_L(8); PG8_BAR; PG8_WAIT_L(0); PG8_MMA(0, 0, At, B0); PG8_BAR; PG8_SCHED;
            PG8_LDB(B1, 0, 1); PG8_STAGE(PG8_SB(0, 0), b2, voffB);
            PG8_BAR; PG8_WAIT_L(0); PG8_MMA(0, 1, At, B1); PG8_BAR;
            PG8_LDA(At, 0, 1); PG8_STAGE(PG8_SA(0, 0), a2, voffA);
            PG8_BAR; PG8_WAIT_L(0); PG8_MMA(1, 0, At, B0); PG8_BAR; PG8_SCHED;
            PG8_STAGE(PG8_SB(0, 1), b2 + hstep, voffB);
            PG8_WAIT_V(6); PG8_BAR; PG8_MMA(1, 1, At, B1); PG8_BAR;
            PG8_LDB(B0, 1, 0); PG8_SCHED; PG8_LDA(At, 1, 0); PG8_STAGE(PG8_SA(0, 1), a2 + hstep, voffA);
            PG8_WAIT_L(8); PG8_BAR; PG8_WAIT_L(0); PG8_MMA(0, 0, At, B0); PG8_BAR; PG8_SCHED;
            PG8_LDB(B1, 1, 1); PG8_STAGE(PG8_SB(1, 0), b3, voffB);
            PG8_BAR; PG8_WAIT_L(0); PG8_MMA(0, 1, At, B1); PG8_BAR;
            PG8_LDA(At, 1, 1); PG8_STAGE(PG8_SA(1, 0), a3, voffA);
            PG8_BAR; PG8_WAIT_L(0); PG8_MMA(1, 0, At, B0); PG8_BAR; PG8_SCHED;
            PG8_STAGE(PG8_SB(1, 1), b3 + hstep, voffB);
            PG8_WAIT_V(6); PG8_BAR; PG8_MMA(1, 1, At, B1); PG8_BAR;
            }
        }
        if constexpr (ALIGN_EPI) { if (wr == 0) PG8_BAR; }
        if constexpr (!Epi::AFTER_DRAIN) { if constexpr (Epi::MIDSCALE || Epi::PREFETCH) E(acc, cur, wr, wc, fr, fq, midst); else E(acc, cur, wr, wc, fr, fq); S.done(cur); }
        if (!has_next) break;
#pragma unroll
        for (int a = 0; a < 2; ++a)
#pragma unroll
            for (int b = 0; b < 2; ++b)
#pragma unroll
                for (int m = 0; m < 4; ++m)
#pragma unroll
                    for (int n = 0; n < 2; ++n) acc[a][b][m][n] = (f32x4){0.f, 0.f, 0.f, 0.f};
        cur = nxt; cA = nA; cB = nB; ++ui;
        if constexpr (ALIGN_EPI) { if (wr == 1) PG8_BAR; }
    }
    PG8_WAIT_V(0);
    if constexpr (!ALIGN_EPI) { if (wr == 0) PG8_BAR; }
    PG8_BAR;
    if constexpr (Epi::AFTER_DRAIN) { E.fused(acc, cur, wr, wc, fr, fq, lds, wid, lane); S.done(cur); }
    if constexpr (Epi::HALF_TAIL) {
        Unit hu; int hh;
        if (S.half_unit(hu, hh)) {
            const char* hA = (const char*)g.A + (size_t)hu.pm * tstep + (size_t)hh * hstep; const char* hB = (const char*)g.Bt + (size_t)hu.pn * tstep;
#pragma unroll
            for (int b = 0; b < 2; ++b)
#pragma unroll
                for (int m = 0; m < 4; ++m)
#pragma unroll
                    for (int n = 0; n < 2; ++n) acc[0][b][m][n] = (f32x4){0.f, 0.f, 0.f, 0.f};
#define HS_STAGE(s_, kt_) do { const int so_ = (s_) * 3 * HTB; const size_t ko_ = (size_t)(kt_) * kstep; PG8_STAGE(so_, hA + ko_, voffA); PG8_STAGE(so_ + HTB, hB + ko_, voffB); PG8_STAGE(so_ + 2 * HTB, hB + hstep + ko_, voffB); } while (0)
            HS_STAGE(0, 0); HS_STAGE(1, 1);
            int st = 0;
            for (int t = 0; t < nt; ++t) {
                if (t + 1 < nt) PG8_WAIT_V(6); else PG8_WAIT_V(0);
                PG8_BAR;
                if (t + 2 < nt) { const int s2 = (st >= 1) ? st - 1 : 2; HS_STAGE(s2, t + 2); }
                const int so = st * 3 * HTB;
#pragma unroll
                for (int n = 0; n < 2; ++n)
#pragma unroll
                    for (int k = 0; k < 2; ++k) { B0[n][k] = *(const PG8_LAS bf16x8*)(lds + so + HTB + boff + n * 2048 + k * 1024); B1[n][k] = *(const PG8_LAS bf16x8*)(lds + so + 2 * HTB + boff + n * 2048 + k * 1024); }
#pragma unroll
                for (int m = 0; m < 4; ++m)
#pragma unroll
                    for (int k = 0; k < 2; ++k) At[m][k] = *(const PG8_LAS bf16x8*)(lds + so + aoff + m * 2048 + k * 1024);
                PG8_WAIT_L(0);
                PG8_MMA(0, 0, At, B0); PG8_MMA(0, 1, At, B1);
                st = (st == 2) ? 0 : st + 1;
            }
            PG8_BAR;
#undef HS_STAGE
            E.half(acc, hu, hh, wr, wc, fr, fq);
        }
    }
#undef PG8_SA
#undef PG8_SB
#undef PG8_STAGE
#undef PG8_LDA
#undef PG8_LDB
#undef PG8_MMA
#undef PG8_WAIT_V
#undef PG8_WAIT_L
#undef PG8_BAR
#undef PG8_SCHED
}
}

#ifndef PG8_SP2
#define PG8_SP2 true
#endif
#ifndef PG8_ALIGN
#define PG8_ALIGN true
#endif
#include <hip/hip_bf16.h>
#include <cmath>
namespace attn_body {
using bf16=__hip_bfloat16;
using bf16x8=__attribute__((ext_vector_type(8)))short;
using s16x4=__attribute__((ext_vector_type(4)))short;
using f32x16=__attribute__((ext_vector_type(16)))float;
using u32x4=__attribute__((ext_vector_type(4)))unsigned;
constexpr int D=64,PITCH=1536,OPITCH=1024;
constexpr int NW=8,QBLK=32,QB=QBLK*NW,KVBLK=64;
__device__ __forceinline__ int crow(int r,int hi){return (r&3)+8*(r>>2)+4*hi;}
#define SBAR() __builtin_amdgcn_sched_barrier(0)
__device__ __forceinline__ void cmask(f32x16&p0,f32x16&p1,int jb,int qrel,int hi){
  const float NEG=-INFINITY; int kb=64*jb+4*hi;
  #pragma unroll
  for(int r=0;r<16;++r){int kv=kb+(r&3)+8*(r>>2); if(kv>qrel)p0[r]=NEG; if(kv+32>qrel)p1[r]=NEG;}
}

__device__ __forceinline__ void wmask(f32x16&p0,f32x16&p1,float fb,float slope2){
  const float NEG=-INFINITY;
  #pragma unroll
  for(int r=0;r<16;++r){ const float c=(float)((r&3)+8*(r>>2)); const float a0=__builtin_fabsf(fb-c), a1=__builtin_fabsf(fb-c-32.f);
    p0[r]=(a0<=128.f)?(p0[r]-slope2*a0):NEG; p1[r]=(a1<=128.f)?(p1[r]-slope2*a1):NEG; }
}
constexpr int NSLOT=3, SLOTB=8192;
constexpr int LDS_K=0, LDS_V=NSLOT*SLOTB, LDS_WS=2*NSLOT*SLOTB, LDS_OST=LDS_WS+NW*64*4, LDS_BYTES=LDS_OST+NW*4096;
constexpr float C2=0.125f*1.4426950408889634f;
__device__ __forceinline__ void glds16(const void*gsrc,unsigned lds_dst){unsigned keep;
  asm volatile("s_mov_b32 %0, m0\n\ts_mov_b32 m0, %2\n\ts_nop 0\n\tglobal_load_lds_dwordx4 %1, off\n\ts_mov_b32 m0, %0":"=&s"(keep):"v"(gsrc),"s"(lds_dst):"memory");}
__device__ __forceinline__ float max3f(float a,float b,float c){float r;asm("v_max3_f32 %0, %1, %2, %3":"=v"(r):"v"(a),"v"(b),"v"(c));return r;}
__device__ __forceinline__ float max2f(float a,float b){float r;asm("v_max_f32_e32 %0, %1, %2":"=v"(r):"v"(a),"v"(b));return r;}
__device__ __forceinline__ float fadd_s(float a,float b){float r;asm("v_add_f32_e32 %0, %1, %2":"=v"(r):"v"(a),"v"(b));return r;}
__device__ __forceinline__ float fsub_s(float a,float b){float r;asm("v_sub_f32_e32 %0, %1, %2":"=v"(r):"v"(a),"v"(b));return r;}
typedef float f32x2_t __attribute__((ext_vector_type(2))); typedef __bf16 bf16x2_t __attribute__((ext_vector_type(2)));
__device__ __forceinline__ unsigned cvtpk_s(float lo,float hi){f32x2_t v={lo,hi};bf16x2_t b=__builtin_convertvector(v,bf16x2_t);return __builtin_bit_cast(unsigned,b);}
#define WAIT_BAR(N) asm volatile("s_waitcnt vmcnt(" #N ") lgkmcnt(0)\n\ts_barrier":::"memory")

__device__ __forceinline__ void qkt(f32x16&p0,f32x16&p1,const char*Kslot,const bf16x8*qr,const f32x16&negm,int r32,int hi){
  const char*kb=Kslot+hi*1024+r32*16;
  #pragma unroll
  for(int d0=0;d0<4;++d0){
    const bf16x8 b0=*reinterpret_cast<const bf16x8*>(kb+d0*2048);
    const bf16x8 b1=*reinterpret_cast<const bf16x8*>(kb+d0*2048+512);
    if(d0==0){p0=__builtin_amdgcn_mfma_f32_32x32x16_bf16(b0,qr[0],negm,0,0,0);p1=__builtin_amdgcn_mfma_f32_32x32x16_bf16(b1,qr[0],negm,0,0,0);}
    else{p0=__builtin_amdgcn_mfma_f32_32x32x16_bf16(b0,qr[d0],p0,0,0,0);p1=__builtin_amdgcn_mfma_f32_32x32x16_bf16(b1,qr[d0],p1,0,0,0);}}
}
typedef __attribute__((address_space(3))) const char* lds_cptr;
typedef short v4i16_t __attribute__((ext_vector_type(4)));
__device__ __forceinline__ void kload8(bf16x8*kf,lds_cptr kp){
  kf[0]=*(const __attribute__((address_space(3))) bf16x8*)(kp);      kf[1]=*(const __attribute__((address_space(3))) bf16x8*)(kp+512);
  kf[2]=*(const __attribute__((address_space(3))) bf16x8*)(kp+2048); kf[3]=*(const __attribute__((address_space(3))) bf16x8*)(kp+2560);
  kf[4]=*(const __attribute__((address_space(3))) bf16x8*)(kp+4096); kf[5]=*(const __attribute__((address_space(3))) bf16x8*)(kp+4608);
  kf[6]=*(const __attribute__((address_space(3))) bf16x8*)(kp+6144); kf[7]=*(const __attribute__((address_space(3))) bf16x8*)(kp+6656);
}
__device__ __forceinline__ void kload2(bf16x8*kf,lds_cptr kp,int j){ kf[2*j]=*(const __attribute__((address_space(3))) bf16x8*)(kp+j*2048); kf[2*j+1]=*(const __attribute__((address_space(3))) bf16x8*)(kp+j*2048+512); }
__device__ __forceinline__ s16x4 vtr(lds_cptr p){ return __builtin_bit_cast(s16x4,__builtin_amdgcn_ds_read_tr16_b64_v4i16((__attribute__((address_space(3))) v4i16_t*)p)); }
__device__ __forceinline__ float rowmax(const f32x16&p0,const f32x16&p1){
  float a=max3f(p0[0],p0[1],p1[0]),b=max3f(p0[2],p0[3],p1[1]);a=max3f(a,p1[2],p1[3]);
  #pragma unroll
  for(int r=4;r<16;r+=4){a=max3f(a,p0[r],p0[r+1]);b=max3f(b,p0[r+2],p0[r+3]);a=max3f(a,p1[r],p1[r+1]);b=max3f(b,p1[r+2],p1[r+3]);}
  const float m=max2f(a,b);
  auto rr=__builtin_amdgcn_permlane32_swap(__float_as_uint(m),__float_as_uint(m),false,false);
  return max2f(__uint_as_float(rr[0]),__uint_as_float(rr[1]));
}
__device__ __forceinline__ void pv(f32x16*o,int vb,bf16x8 pa0,bf16x8 pa1,bf16x8 pa2,bf16x8 pa3){
  #pragma unroll
  for(int d0=0;d0<2;++d0){s16x4 lo[4],hi[4];
    #pragma unroll
    for(int ks=0;ks<4;++ks){
      asm volatile("ds_read_b64_tr_b16 %0,%1 offset:%c2":"=&v"(lo[ks]):"v"(vb),"i"(d0*4096+ks*1024):"memory");
      asm volatile("ds_read_b64_tr_b16 %0,%1 offset:%c2":"=&v"(hi[ks]):"v"(vb),"i"(d0*4096+ks*1024+512):"memory");}
    asm volatile("s_waitcnt lgkmcnt(0)":::"memory");SBAR();
    #define PK(k) (bf16x8){lo[k][0],lo[k][1],lo[k][2],lo[k][3],hi[k][0],hi[k][1],hi[k][2],hi[k][3]}
    o[d0]=__builtin_amdgcn_mfma_f32_32x32x16_bf16(pa0,PK(0),o[d0],0,0,0);
    o[d0]=__builtin_amdgcn_mfma_f32_32x32x16_bf16(pa1,PK(1),o[d0],0,0,0);
    o[d0]=__builtin_amdgcn_mfma_f32_32x32x16_bf16(pa2,PK(2),o[d0],0,0,0);
    o[d0]=__builtin_amdgcn_mfma_f32_32x32x16_bf16(pa3,PK(3),o[d0],0,0,0);
    #undef PK
  }
}
#ifndef ATTN_STORE16
#define ATTN_STORE16(p,v) (*(u32x4*)(p)=(v))
#endif
template<int MODE,int THRL,bool NOMAX> __device__ __forceinline__ void attn_unit(const bf16*Qs,const bf16*__restrict__ Ks,const bf16*__restrict__ Vs,bf16*Os,int S,int q0,float sink2,float slope2,float*ssq,char*shm,int tid_in){
  int tid_=tid_in; asm volatile("":"+v"(tid_)); const int tid=tid_,lane=tid&63,r32=lane&31,hi=lane>>5; const int wid=__builtin_amdgcn_readfirstlane(tid>>6);
  int kt0=0,kend=S/KVBLK;
  if(MODE==1){ kt0=(q0>=128?(q0-128):0)/KVBLK; const int ke=q0+QB+128; kend=(ke<S?ke:S)/KVBLK; }
  const bf16*Qw=Qs+(long)(q0+wid*QBLK)*PITCH;
  const bf16*Kh=Ks+(long)kt0*KVBLK*PITCH,*Vh=Vs+(long)kt0*KVBLK*PITCH;
  const unsigned lds0=(unsigned)(uintptr_t)shm;
  float*wsf=(float*)(shm+LDS_WS)+wid*64;
  const bf16*ksrc=Kh+(long)lane*PITCH+wid*8;
  const bf16*vsrc=Vh+(long)(16*(wid&3)+(lane>>2))*PITCH+(wid>>2)*32+(lane&3)*8;
  const unsigned kdst=lds0+LDS_K+wid*1024, vdst=lds0+LDS_V+wid*1024;
  #define DMA_K(t,slot) glds16(ksrc+(long)(t)*KVBLK*PITCH,(unsigned)__builtin_amdgcn_readfirstlane(kdst+(slot)))
  #define DMA_V(t,slot) glds16(vsrc+(long)(t)*KVBLK*PITCH,(unsigned)__builtin_amdgcn_readfirstlane(vdst+(slot)))
  const int vb0=(int)(lds0+LDS_V)+((lane>>4)&1)*32+(lane&3)*8+(4*hi+((lane&15)>>2))*64;
  const char*Kbase=shm+LDS_K; bf16x8 kf[8];
  const lds_cptr shm3=(lds_cptr)shm; const lds_cptr kp0=shm3+LDS_K+hi*1024+r32*16; const lds_cptr vp0=shm3+LDS_V+((lane>>4)&1)*32+(lane&3)*8+(4*hi+((lane&15)>>2))*64;
  const int NT=kend-kt0;
  DMA_K(0,0);DMA_V(0,0);DMA_K(1,SLOTB);
  bf16x8 qr[4];
  #pragma unroll
  for(int d0=0;d0<4;++d0)qr[d0]=*reinterpret_cast<const bf16x8*>(&Qw[(long)r32*PITCH+d0*16+hi*8]);
  float mhat=0.f,l_reg=0.f;f32x16 o[2];o[0]=f32x16{};o[1]=f32x16{};f32x16 negm=f32x16{};
  if(MODE==1){ mhat=sink2; l_reg=(hi==0)?1.f:0.f;
    #pragma unroll
    for(int r=0;r<16;++r)negm[r]=-sink2; }
  if(!NOMAX)asm volatile("":"+v"(negm));
  f32x16 lsum=f32x16{}; bf16x8 onesv;
  #pragma unroll
  for(int i_=0;i_<8;++i_)onesv[i_]=(short)0x3F80;
  asm volatile("":"+v"(onesv));
  const int qrel=wid*QBLK+r32;
  const int qk0=q0+qrel-kt0*KVBLK-4*hi;
  #define CMASK(P0,P1,t) do{ if(MODE==1) wmask(P0,P1,(float)(qk0-(t)*KVBLK),slope2); }while(0)
  bool resc=false;
  #define START(P0,P1) do{ resc=false; if(!NOMAX){ const float rm=rowmax(P0,P1); \
    if(MODE==0 || __any(rm>(float)THRL)) { const float dl=(MODE==0)?rm:__builtin_fmaxf(rm,0.f); mhat=fadd_s(mhat,dl); if(MODE==1) l_reg*=__builtin_amdgcn_exp2f(-dl); \
      _Pragma("unroll") for(int r=0;r<16;++r){P0[r]=fsub_s(P0[r],dl);P1[r]=fsub_s(P1[r],dl);} \
      _Pragma("unroll") for(int r=0;r<16;++r)negm[r]=-mhat; asm volatile("":"+v"(negm)); } } \
    _Pragma("unroll") for(int r=0;r<16;++r)P0[r]=__builtin_amdgcn_exp2f(P0[r]); }while(0)
  #define RESC() do{ if(resc){ asm volatile("s_waitcnt lgkmcnt(0)":::"memory"); \
      _Pragma("unroll") for(int d_=0;d_<2;++d_) _Pragma("unroll") for(int r=0;r<16;++r)o[d_][r]*=wsf[crow(r,hi)]; } }while(0)
  f32x16 pA0,pA1,pB0,pB1;
  int sl_prev=0,sl_cur=0,sl_next=SLOTB;
  #define ROT() do{sl_prev=sl_cur;sl_cur=sl_next;sl_next=(sl_next==(NSLOT-1)*SLOTB)?0:sl_next+SLOTB;}while(0)
  DMA_K(2,2*SLOTB);
  WAIT_BAR(3);
  qkt(pA0,pA1,Kbase,qr,(NOMAX?f32x16{}:negm),r32,hi);asm volatile("s_nop 15\n\ts_nop 7":"+v"(pA0),"+v"(pA1));CMASK(pA0,pA1,0);
  START(pA0,pA1);
  _Pragma("unroll") for(int r=0;r<16;++r)pA1[r]=__builtin_amdgcn_exp2f(pA1[r]);
  WAIT_BAR(0);
  DMA_K(3,0);DMA_V(1,SLOTB);
  ROT();
  kload8(kf,kp0+sl_cur);
  WAIT_BAR(2);
  s16x4 vlo[8],vhi[8]; u32x4 pw0,pw1,pw2,pw3;
  #define PKW(P,B) cvtpk_s(P[B],P[B+1])
  #define PAF(k) __builtin_bit_cast(bf16x8,pw##k)
  #define VFR(i) (bf16x8){vlo[i][0],vlo[i][1],vlo[i][2],vlo[i][3],vhi[i][0],vhi[i][1],vhi[i][2],vhi[i][3]}
  #define PIN(x) asm volatile("":"+v"(x))
  #define MX3(a,b,c) __builtin_fmaxf(__builtin_fmaxf((a),(b)),(c))
  #define GAPA(MF,A0,A1,A2,A3,W0,W1,PW) do{ MF; if(!NOMAX){ sacc+=A0; sacc+=A1; sacc+=A2; sacc+=A3; PIN(sacc); } W0; W1; PIN(PW); SBAR(); }while(0)
  #define LSUM(k) do{ if(NOMAX){ lsum=__builtin_amdgcn_mfma_f32_32x32x16_bf16(PAF(k),onesv,lsum,0,0,0); SBAR(); } }while(0)
  #define NEGM (NOMAX?f32x16{}:negm)
  #define EX(v) __builtin_amdgcn_exp2f(v)
  #define GAPB(MF,X,B) do{ MF; X[B]=EX(X[B]); X[B+1]=EX(X[B+1]); X[B+2]=EX(X[B+2]); X[B+3]=EX(X[B+3]); PIN(X); SBAR(); }while(0)
  #define VRD(i) do{ vlo[i]=vtr(vp_+(((i)>>2)*4096+((i)&3)*1024)); vhi[i]=vtr(vp_+(((i)>>2)*4096+((i)&3)*1024+512)); }while(0)
  #define KRD(G,j) do{ if(G){ kload2(kf,kp0+sl_next,j); SBAR(); } }while(0)
  #define STEP(C0,C1,P0,P1,t,GK,GV,GL) do{ SBAR(); \
    const lds_cptr vp_=vp0+sl_prev; \
    VRD(0); SBAR(); float sacc=(P0[0]+P0[1]); \
    GAPA(C0=__builtin_amdgcn_mfma_f32_32x32x16_bf16(kf[0],qr[0],NEGM,0,0,0), P0[2],P0[3],P0[4],P0[5],     pw0[0]=PKW(P0,0), pw0[1]=PKW(P0,2), pw0); \
    VRD(4); SBAR(); GAPA(C1=__builtin_amdgcn_mfma_f32_32x32x16_bf16(kf[1],qr[0],NEGM,0,0,0), P0[6],P0[7],P0[8],P0[9],     pw0[2]=PKW(P0,4), pw0[3]=PKW(P0,6), pw0); \
    VRD(1); SBAR(); GAPA(C0=__builtin_amdgcn_mfma_f32_32x32x16_bf16(kf[2],qr[1],C0,0,0,0),   P0[10],P0[11],P0[12],P0[13], pw1[0]=PKW(P0,8), pw1[1]=PKW(P0,10), pw1); \
    VRD(5); SBAR(); GAPA(C1=__builtin_amdgcn_mfma_f32_32x32x16_bf16(kf[3],qr[1],C1,0,0,0),   P0[14],P0[15],P1[0],P1[1],   pw1[2]=PKW(P0,12),pw1[3]=PKW(P0,14), pw1); \
    VRD(2); SBAR(); GAPA(C0=__builtin_amdgcn_mfma_f32_32x32x16_bf16(kf[4],qr[2],C0,0,0,0),   P1[2],P1[3],P1[4],P1[5],     pw2[0]=PKW(P1,0), pw2[1]=PKW(P1,2), pw2); \
    VRD(6); SBAR(); GAPA(C1=__builtin_amdgcn_mfma_f32_32x32x16_bf16(kf[5],qr[2],C1,0,0,0),   P1[6],P1[7],P1[8],P1[9],     pw2[2]=PKW(P1,4), pw2[3]=PKW(P1,6), pw2); \
    VRD(3); SBAR(); GAPA(C0=__builtin_amdgcn_mfma_f32_32x32x16_bf16(kf[6],qr[3],C0,0,0,0),   P1[10],P1[11],P1[12],P1[13], pw3[0]=PKW(P1,8), pw3[1]=PKW(P1,10), pw3); \
    VRD(7); SBAR(); GAPA(C1=__builtin_amdgcn_mfma_f32_32x32x16_bf16(kf[7],qr[3],C1,0,0,0),   P1[14],P1[15],0.f,0.f,       pw3[2]=PKW(P1,12),pw3[3]=PKW(P1,14), pw3); \
    if(!NOMAX)l_reg+=sacc; \
    if(GK){DMA_K((t)+3,sl_cur);} if(GV){DMA_V((t)+1,sl_next);} \
    CMASK(C0,C1,t); \
    if(!NOMAX){ float a=MX3(C0[0],C0[1],C1[0]),b=MX3(C0[2],C0[3],C1[1]); a=MX3(a,C1[2],C1[3]); \
      _Pragma("unroll") for(int r=4;r<16;r+=4){a=MX3(a,C0[r],C0[r+1]);b=MX3(b,C0[r+2],C0[r+3]);a=MX3(a,C1[r],C1[r+1]);b=MX3(b,C1[r+2],C1[r+3]);} \
      float rm=__builtin_fmaxf(a,b); { auto rr=__builtin_amdgcn_permlane32_swap(__float_as_uint(rm),__float_as_uint(rm),false,false); rm=__builtin_fmaxf(__uint_as_float(rr[0]),__uint_as_float(rr[1])); } \
      resc=false; \
      if(__builtin_expect(__any(rm>(float)THRL),0)){ const float dl=__builtin_fmaxf(rm,0.f); mhat+=dl; \
        _Pragma("unroll") for(int r=0;r<16;++r){C0[r]-=dl;C1[r]-=dl;} \
        _Pragma("unroll") for(int r=0;r<16;++r)negm[r]=-mhat; asm volatile("":"+v"(negm)); \
        const float f=__builtin_amdgcn_exp2f(-dl); l_reg*=f; if(hi==0)wsf[r32]=f; resc=true; } } \
    SBAR(); \
    GAPB(o[0]=__builtin_amdgcn_mfma_f32_32x32x16_bf16(PAF(0),VFR(0),o[0],0,0,0), C0,0); \
    GAPB(o[1]=__builtin_amdgcn_mfma_f32_32x32x16_bf16(PAF(0),VFR(4),o[1],0,0,0), C0,4); LSUM(0); \
    KRD(GL,0); GAPB(o[0]=__builtin_amdgcn_mfma_f32_32x32x16_bf16(PAF(1),VFR(1),o[0],0,0,0), C0,8); \
    KRD(GL,1); GAPB(o[1]=__builtin_amdgcn_mfma_f32_32x32x16_bf16(PAF(1),VFR(5),o[1],0,0,0), C0,12); LSUM(1); \
    KRD(GL,2); GAPB(o[0]=__builtin_amdgcn_mfma_f32_32x32x16_bf16(PAF(2),VFR(2),o[0],0,0,0), C1,0); \
    KRD(GL,3); GAPB(o[1]=__builtin_amdgcn_mfma_f32_32x32x16_bf16(PAF(2),VFR(6),o[1],0,0,0), C1,4); LSUM(2); \
    GAPB(o[0]=__builtin_amdgcn_mfma_f32_32x32x16_bf16(PAF(3),VFR(3),o[0],0,0,0), C1,8); \
    GAPB(o[1]=__builtin_amdgcn_mfma_f32_32x32x16_bf16(PAF(3),VFR(7),o[1],0,0,0), C1,12); LSUM(3); \
    }while(0)
  int t=1;
  for(;t+5<NT;t+=2){
    STEP(pB0,pB1,pA0,pA1,t,true,true,true);     WAIT_BAR(2); RESC(); ROT();
    STEP(pA0,pA1,pB0,pB1,t+1,true,true,true);   WAIT_BAR(2); RESC(); ROT();
  }
  #define ENDW(tt) do{ if((tt)+3<NT){WAIT_BAR(2);} else if((tt)+2<NT){WAIT_BAR(1);} else {WAIT_BAR(0);} }while(0)
  for(;t+1<NT;t+=2){
    STEP(pB0,pB1,pA0,pA1,t,(t+3<NT),(t+1<NT),(t+1<NT));       ENDW(t);   RESC(); ROT();
    STEP(pA0,pA1,pB0,pB1,t+1,(t+4<NT),(t+2<NT),(t+2<NT));     ENDW(t+1); RESC(); ROT();
  }
  STEP(pB0,pB1,pA0,pA1,NT-1,false,false,false); RESC();
  { float sacc=pB0[0]+pB0[1]; _Pragma("unroll") for(int r=2;r<16;++r)sacc+=pB0[r]; _Pragma("unroll") for(int r=0;r<16;++r)sacc+=pB1[r]; l_reg+=sacc;
    pw0=(u32x4){PKW(pB0,0),PKW(pB0,2),PKW(pB0,4),PKW(pB0,6)};pw1=(u32x4){PKW(pB0,8),PKW(pB0,10),PKW(pB0,12),PKW(pB0,14)};pw2=(u32x4){PKW(pB1,0),PKW(pB1,2),PKW(pB1,4),PKW(pB1,6)};pw3=(u32x4){PKW(pB1,8),PKW(pB1,10),PKW(pB1,12),PKW(pB1,14)};
    SBAR(); pv(o,vb0+sl_cur,PAF(0),PAF(1),PAF(2),PAF(3)); LSUM(0); LSUM(1); LSUM(2); LSUM(3); }
  #undef PKW
  #undef PAF
  #undef VFR
  #undef PIN
  #undef MX3
  #undef GAPA
  #undef LSUM
  #undef GAPB
  #undef EX
  #undef VRD
  #undef KRD
  #undef STEP
  #undef ENDW
  {auto rr=__builtin_amdgcn_permlane32_swap(__float_as_uint(l_reg),__float_as_uint(l_reg),false,false);l_reg=__uint_as_float(rr[0])+__uint_as_float(rr[1]);}
  if(hi==0)wsf[32+r32]=l_reg;asm volatile("s_waitcnt lgkmcnt(0)":::"memory");
  float rli[16];
  #pragma unroll
  for(int r=0;r<16;++r)rli[r]=NOMAX?__builtin_amdgcn_rcpf(lsum[r]):__builtin_amdgcn_rcpf(wsf[32+crow(r,hi)]);
  #undef NEGM
  bf16*Ow=Os+(long)(q0+wid*QBLK)*OPITCH;
  { bf16*stg=(bf16*)(shm+LDS_OST)+wid*2048;
    #pragma unroll
    for(int r=0;r<16;++r){const int orow=crow(r,hi);
      #pragma unroll
      for(int d0=0;d0<2;++d0)stg[orow*64+d0*32+r32]=__float2bfloat16(o[d0][r]*rli[r]);}
    asm volatile("s_waitcnt lgkmcnt(0)":::"memory");
    #pragma unroll
    for(int i=0;i<4;++i){const int row=i*8+(lane>>3),ch=lane&7; const u32x4 v=*(const u32x4*)(stg+row*64+ch*8); ATTN_STORE16(Ow+(long)row*OPITCH+ch*8,v);
      float sq=0.f;
      #pragma unroll
      for(int k=0;k<4;++k){const float a=__uint_as_float(v[k]<<16),b=__uint_as_float(v[k]&0xffff0000u); sq+=a*a+b*b;}
      sq+=__shfl_xor(sq,1); sq+=__shfl_xor(sq,2); sq+=__shfl_xor(sq,4);
      if(ch==0)ssq[(long)(q0+wid*QBLK+row)*16]=sq;} }
  asm volatile("s_waitcnt lgkmcnt(0)\n\ts_barrier":::"memory");
  #undef DMA_K
  #undef DMA_V
  #undef CMASK
  #undef START
  #undef RESC
  #undef ROT
}
constexpr int ATTN_LDS_BYTES=LDS_BYTES;
#undef SBAR
#undef WAIT_BAR
}
#include <hip/hip_cooperative_groups.h>
namespace cg = cooperative_groups;
constexpr int NWAVES = 8;
#ifndef PHASES
#define PHASES 0xffff
#endif
#define PH(n) if constexpr ((PHASES >> (n)) & 1)
#ifndef REP_SYNC
#define REP_SYNC 1
#endif
#ifndef REP_PRO
#define REP_PRO 1
#endif
#ifndef REP_EPOST
#define REP_EPOST 1
#endif
#ifndef REP_ONORM
#define REP_ONORM 1
#endif
#if REP_SYNC == 2
#define GSYNC() do { xcd_barrier(xbar, MYTID() == 0); xcd_barrier(xbar, MYTID() == 0); } while (0)
#else
#define GSYNC() xcd_barrier(xbar, MYTID() == 0)
#endif
#ifndef GEMM_SP2
#define GEMM_SP2 true
#endif
#ifndef HALF_TAIL_GU
#define HALF_TAIL_GU false
#endif
#ifndef SWIGLU_ALIGN
#define SWIGLU_ALIGN true
#endif
#ifndef REP_GU
#define REP_GU REP_GEMM
#endif
#ifndef REP_DN
#define REP_DN REP_GEMM
#endif
#ifndef REP_ATTN
#define REP_ATTN 1
#endif
#ifndef REP_GEMM
#define REP_GEMM 1
#endif
constexpr int DM = 1024, DFF = 2816, NIN = 1536, DEPTH = 2;
constexpr int M_P = 32768, M_S = 16384, M = M_P + M_S;
constexpr int S_P = 16384, S_S = 8192;
constexpr float EPS = 1e-6f;
constexpr float LOG2E = 1.4426950408889634f;
constexpr size_t MiB = 1u << 20;
constexpr int RING_BYTES = 131072, LDS_BYTES = 147456;
constexpr size_t W_LAYER = 38 * MiB, W_GU1 = 0, W_D1 = 11 * MiB, W_IN = 16 * MiB + MiB / 2, W_OUT = 19 * MiB + MiB / 2, W_GU2 = 21 * MiB + MiB / 2, W_D2 = 32 * MiB + MiB / 2;
constexpr size_t WS_ACT = 76 * MiB, WS_BIG = 172 * MiB, WS_O = WS_BIG + 144 * MiB, WS_RSX = 436 * MiB, WS_SSQ = 437 * MiB, WS_END = 441 * MiB;
constexpr int YLD = 2048;
constexpr size_t WS_CTL = WS_RSX + 512 * 1024, CTL_BYTES = 16384;
constexpr int MISC_OFF = RING_BYTES + 320;
static_assert(W_D2 + (size_t)DM * DFF * 2 == W_LAYER && WS_ACT + (size_t)M * DM * 2 == WS_BIG && WS_BIG + (size_t)M * DFF * 2 == WS_RSX && WS_O + (size_t)M * DM * 2 <= WS_END, "ws map");
#define LAS __attribute__((address_space(3)))
typedef unsigned short bfu;
typedef unsigned v4u __attribute__((ext_vector_type(4)));
typedef unsigned v2u __attribute__((ext_vector_type(2)));
typedef float f32x4 __attribute__((ext_vector_type(4)));
#define LDS_WAIT() asm volatile("s_waitcnt lgkmcnt(0)" ::: "memory")
__device__ __forceinline__ unsigned pk2(float lo, float hi) { return pg8::cvt_pk_bf16(lo, hi); }
__device__ __forceinline__ float bflo(unsigned w) { return __uint_as_float(w << 16); }
__device__ __forceinline__ float bfhi(unsigned w) { return __uint_as_float(w & 0xffff0000u); }
__device__ __forceinline__ float wave_sum(float v) {
#pragma unroll
    for (int o = 1; o < 64; o <<= 1) v += __shfl_xor(v, o);
    return v;
}
__device__ __forceinline__ int lsg(int x) { asm volatile("" : "+s"(x)); return x; }
__device__ __forceinline__ float dot4(f32x4 a) { return (a.x * a.x + a.y * a.y) + (a.z * a.z + a.w * a.w); }

__device__ __forceinline__ void transpose_item(const float* W, int K, int N, bfu* WT, const float* g, const float* g2, int mode, LAS float* scr, int item, int lane) {
    const int nblk = N / 32, kb = item / nblk, nb = item % nblk, k0 = 64 * kb, n0 = 32 * nb;
    const float* gp = g ? ((g2 && k0 >= 512) ? g2 + (k0 - 512) : g + k0) : nullptr;
#pragma unroll
    for (int i = 0; i < 32; ++i) { const int kk = 2 * i + (lane >> 5); const float gv = gp ? gp[kk] : 1.0f; scr[kk * 33 + (lane & 31)] = W[(size_t)(k0 + kk) * N + n0 + (lane & 31)] * gv; }
    LDS_WAIT(); asm volatile("" ::: "memory");
    const int c = lane & 7;
    const int r0 = (mode == 0) ? n0 : (mode == 3) ? ((n0 & ~255) + 128 * ((n0 >> 5) & 1) + 32 * ((n0 >> 6) & 3)) : (256 * (n0 >> 7) + (n0 & 127) + (mode == 2 ? 128 : 0));
#pragma unroll
    for (int j = 0; j < 4; ++j) { const int n = (lane >> 3) + 8 * j; const LAS float* s = scr + (8 * c) * 33 + n;
        v4u o; o.x = pk2(s[0 * 33], s[1 * 33]); o.y = pk2(s[2 * 33], s[3 * 33]); o.z = pk2(s[4 * 33], s[5 * 33]); o.w = pk2(s[6 * 33], s[7 * 33]);
        *(v4u*)(WT + (size_t)(r0 + n) * K + k0 + 8 * c) = o; }
    LDS_WAIT(); asm volatile("" ::: "memory");
}
struct TiDesc { const float* W; bfu* WT; const float* g; const float* g2; int K, N, mode, item; };
__device__ __forceinline__ void ti_load(const TiDesc& d, int lane, f32x4 (&v)[8], f32x4 (&gv)[2], size_t& dst) {
    const int nblk = d.N / 32, kb = d.item / nblk, nb = d.item % nblk, k0 = 64 * kb, n0 = 32 * nb, ng = lane & 7, kg = lane >> 3;
    const float* src = d.W + (size_t)(k0 + 8 * kg) * d.N + n0 + 4 * ng;
#pragma unroll
    for (int i = 0; i < 8; ++i) v[i] = *(const f32x4*)(src + (size_t)i * d.N);
    if (d.g) { const float* gp = ((d.g2 && k0 >= 512) ? d.g2 + (k0 - 512) : d.g + k0) + 8 * kg; gv[0] = *(const f32x4*)gp; gv[1] = *(const f32x4*)(gp + 4); }
    else { gv[0] = (f32x4){1.f, 1.f, 1.f, 1.f}; gv[1] = gv[0]; }
    const int r0 = (d.mode == 0) ? n0 : (d.mode == 3) ? ((n0 & ~255) + 128 * ((n0 >> 5) & 1) + 32 * ((n0 >> 6) & 3)) : (256 * (n0 >> 7) + (n0 & 127) + (d.mode == 2 ? 128 : 0));
    dst = (size_t)(r0 + 4 * ng) * d.K + k0 + 8 * kg;
}
__device__ __forceinline__ void ti_store(const TiDesc& d, const f32x4 (&v)[8], const f32x4 (&gv)[2], size_t dst) {
#pragma unroll
    for (int j = 0; j < 4; ++j) { v4u o; o.x = pk2(v[0][j] * gv[0][0], v[1][j] * gv[0][1]); o.y = pk2(v[2][j] * gv[0][2], v[3][j] * gv[0][3]); o.z = pk2(v[4][j] * gv[1][0], v[5][j] * gv[1][1]); o.w = pk2(v[6][j] * gv[1][2], v[7][j] * gv[1][3]);
        *(v4u*)(d.WT + dst + (size_t)j * d.K) = o; }
}
__device__ __forceinline__ void unpack8(const v4u w, float (&x)[8]) { x[0] = bflo(w.x); x[1] = bfhi(w.x); x[2] = bflo(w.y); x[3] = bfhi(w.y); x[4] = bflo(w.z); x[5] = bfhi(w.z); x[6] = bflo(w.w); x[7] = bfhi(w.w); }
__device__ __forceinline__ v4u pack8(const float (&x)[8]) { v4u r; r.x = pk2(x[0], x[1]); r.y = pk2(x[2], x[3]); r.z = pk2(x[4], x[5]); r.w = pk2(x[6], x[7]); return r; }
template <int R> __device__ __forceinline__ void wave_sum_n(float (&v)[R]) {
#pragma unroll
    for (int o = 1; o < 64; o <<= 1) {
#pragma unroll
        for (int r = 0; r < R; ++r) v[r] += __shfl_xor(v[r], o); }
}
__device__ __forceinline__ void e_first_rows4(const float* x0, bfu* xb0, float* rsx, int lane) {
    f32x4 v[4][2][2];
#pragma unroll
    for (int r = 0; r < 4; ++r)
#pragma unroll
        for (int h = 0; h < 2; ++h) { const f32x4* p = (const f32x4*)(x0 + (size_t)r * DM + 512 * h + 8 * lane); v[r][h][0] = p[0]; v[r][h][1] = p[1]; }
    float ss[4];
#pragma unroll
    for (int r = 0; r < 4; ++r) { ss[r] = (dot4(v[r][0][0]) + dot4(v[r][0][1])) + (dot4(v[r][1][0]) + dot4(v[r][1][1]));
#pragma unroll
        for (int h = 0; h < 2; ++h) { v4u w; w.x = pk2(v[r][h][0].x, v[r][h][0].y); w.y = pk2(v[r][h][0].z, v[r][h][0].w); w.z = pk2(v[r][h][1].x, v[r][h][1].y); w.w = pk2(v[r][h][1].z, v[r][h][1].w);
            *(v4u*)(xb0 + (size_t)r * DM + 512 * h + 8 * lane) = w; } }
    wave_sum_n<4>(ss);
    if (lane < 4) { const float sv = lane == 0 ? ss[0] : lane == 1 ? ss[1] : lane == 2 ? ss[2] : ss[3]; rsx[lane] = __builtin_amdgcn_rsqf(sv * (1.f / DM) + EPS); }
}
template <bool FINAL, int R> __device__ __forceinline__ void e_post_rows(const bfu* y0, bfu* xb0, float* rsx, float* out0, const float* gpost, float scale, int lane) {
    v4u yw[R][2], xw[R][2];
#pragma unroll
    for (int r = 0; r < R; ++r)
#pragma unroll
        for (int h = 0; h < 2; ++h) { yw[r][h] = *(const v4u*)(y0 + (size_t)r * YLD + 512 * h + 8 * lane); xw[r][h] = *(const v4u*)(xb0 + (size_t)r * DM + 512 * h + 8 * lane); }
    asm volatile("" ::: "memory");
    f32x4 g[2][2];
#pragma unroll
    for (int h = 0; h < 2; ++h) { const f32x4* p = (const f32x4*)(gpost + 512 * h + 8 * lane); g[h][0] = p[0]; g[h][1] = p[1]; }
    float sy[R];
#pragma unroll
    for (int r = 0; r < R; ++r) { float a = 0.f;
#pragma unroll
        for (int h = 0; h < 2; ++h) { float y[8]; unpack8(yw[r][h], y);
#pragma unroll
            for (int k = 0; k < 8; ++k) a += y[k] * y[k]; }
        sy[r] = a; }
    wave_sum_n<R>(sy);
    float sx[R];
#pragma unroll
    for (int r = 0; r < R; ++r) { const float rs = __builtin_amdgcn_rsqf(sy[r] * (1.f / DM) + EPS) * scale; float a = 0.f;
#pragma unroll
        for (int h = 0; h < 2; ++h) { float y[8], x[8]; unpack8(yw[r][h], y); unpack8(xw[r][h], x);
            const float gg[8] = {g[h][0].x, g[h][0].y, g[h][0].z, g[h][0].w, g[h][1].x, g[h][1].y, g[h][1].z, g[h][1].w};
#pragma unroll
            for (int k = 0; k < 8; ++k) { x[k] = x[k] + y[k] * rs * gg[k]; a += x[k] * x[k]; }
            if (FINAL) { f32x4* po = (f32x4*)(out0 + (size_t)r * DM + 512 * h + 8 * lane); po[0] = (f32x4){x[0], x[1], x[2], x[3]}; po[1] = (f32x4){x[4], x[5], x[6], x[7]}; }
            else *(v4u*)(xb0 + (size_t)r * DM + 512 * h + 8 * lane) = pack8(x); }
        sx[r] = a; }
    if (!FINAL) { wave_sum_n<R>(sx);
        float sv = sx[0];
#pragma unroll
        for (int r = 1; r < R; ++r) sv = (lane == r) ? sx[r] : sv;
        if (lane < R) rsx[lane] = __builtin_amdgcn_rsqf(sv * (1.f / DM) + EPS); }
}
__device__ __forceinline__ void e_onorm_rows4(bfu* o0, int lane) {
    v4u w[4][2];
#pragma unroll
    for (int r = 0; r < 4; ++r)
#pragma unroll
        for (int h = 0; h < 2; ++h) w[r][h] = *(const v4u*)(o0 + (size_t)r * DM + 512 * h + 8 * lane);
    float ss[8];
#pragma unroll
    for (int r = 0; r < 4; ++r)
#pragma unroll
        for (int h = 0; h < 2; ++h) { float x[8]; unpack8(w[r][h], x); float a = 0.f;
#pragma unroll
            for (int k = 0; k < 8; ++k) a += x[k] * x[k];
            ss[2 * r + h] = a; }
    wave_sum_n<8>(ss);
#pragma unroll
    for (int r = 0; r < 4; ++r)
#pragma unroll
        for (int h = 0; h < 2; ++h) { float x[8]; unpack8(w[r][h], x); const float rstd = __builtin_amdgcn_rsqf(ss[2 * r + h] * (1.f / 512.f) + EPS);
#pragma unroll
            for (int k = 0; k < 8; ++k) x[k] *= rstd;
            *(v4u*)(o0 + (size_t)r * DM + 512 * h + 8 * lane) = pack8(x); }
}
#define XB_TMO      128
#define XB_XCNT(j)  (256  + 64 * (j))
#define XB_XSUB(j)  (1280 + 64 * (j))
#define XB_XGEN(j)  (2304 + 64 * (j))
#define XB_TOP      3328
#define XB_TOPGEN   3392
#define XCD_BAR_WORDS 3456
#define XB_SPIN_CAP (1u << 18)

__device__ __forceinline__ unsigned xb_ld(unsigned* p)              { return __hip_atomic_load(p, __ATOMIC_RELAXED, __HIP_MEMORY_SCOPE_AGENT); }
__device__ __forceinline__ unsigned xb_add(unsigned* p, unsigned v) { return __hip_atomic_fetch_add(p, v, __ATOMIC_RELAXED, __HIP_MEMORY_SCOPE_AGENT); }
__device__ __forceinline__ unsigned xb_xcc_id() { return (unsigned)__builtin_amdgcn_s_getreg((3 << 11) | 20) & 0xFu; }
#define XB_SPIN(cond, bar) do { unsigned _sp = 0; while (cond) { __builtin_amdgcn_s_sleep(1); \
    if ((++_sp & 255u) == 0u) { if (xb_ld(&(bar)[XB_TMO])) break; if (_sp > XB_SPIN_CAP) { atomicAdd(&(bar)[XB_TMO], 1u); break; } } } } while (0)

struct XcdBarrier {
    unsigned* bar; unsigned x;
    volatile LAS unsigned* st;
};

__device__ __forceinline__ XcdBarrier xcd_barrier_post(unsigned* bar, volatile LAS unsigned* st, bool t0) {
    XcdBarrier b; b.bar = bar; b.x = xb_xcc_id(); b.st = st;
    if (t0) (void)xb_add(&bar[XB_XCNT(b.x)], 1u);
    return b;
}
__device__ __forceinline__ void xcd_barrier_complete(unsigned* bar, unsigned x, unsigned& nloc, unsigned& nx) {
    const unsigned G = gridDim.x * gridDim.y * gridDim.z;
    unsigned sum, cnt, mine, sp = 0u;
    for (;;) {
        sum = 0u; cnt = 0u; mine = 0u;
#pragma unroll
        for (unsigned j = 0; j < 16; ++j) { const unsigned c = xb_ld(&bar[XB_XCNT(j)]); sum += c; cnt += (c > 0u) ? 1u : 0u; mine = (j == x) ? c : mine; }
        if (sum == G) break;
        __builtin_amdgcn_s_sleep(1);
        if ((++sp & 255u) == 0u) { if (xb_ld(&bar[XB_TMO])) break; if (sp > XB_SPIN_CAP) { atomicAdd(&bar[XB_TMO], 1u); break; } }
    }
    nloc = mine > 0u ? mine : 1u; nx = cnt > 0u ? cnt : 1u;
}

__device__ __forceinline__ void xcd_barrier(const XcdBarrier& b, bool t0) {
    asm volatile("s_waitcnt vmcnt(0)" ::: "memory");
    __syncthreads();
    if (t0) {
        unsigned* bar = b.bar;
        __builtin_amdgcn_s_waitcnt(0);
        unsigned nloc = b.st[0], nx = b.st[1];
        if (nloc == 0u) { xcd_barrier_complete(bar, b.x, nloc, nx); b.st[0] = nloc; b.st[1] = nx; }
        const unsigned old = xb_add(&bar[XB_XSUB(b.x)], 1u);
        const unsigned gen = old / nloc;
        if (old + 1u == (gen + 1u) * nloc) {
            __builtin_amdgcn_fence(__ATOMIC_RELEASE, "agent");
            asm volatile("s_waitcnt vmcnt(0)" ::: "memory");
            const unsigned og = xb_add(&bar[XB_TOP], 1u);
            const unsigned tg = og / nx;
            if (og + 1u == (tg + 1u) * nx) xb_add(&bar[XB_TOPGEN], 1u);
            else XB_SPIN(xb_ld(&bar[XB_TOPGEN]) == tg, bar);
            __builtin_amdgcn_fence(__ATOMIC_ACQUIRE, "agent");
            xb_add(&bar[XB_XGEN(b.x)], 1u);
            asm volatile("s_waitcnt vmcnt(0)" ::: "memory");
        } else {
            XB_SPIN(xb_ld(&bar[XB_XGEN(b.x)]) == gen, bar);
            __builtin_amdgcn_fence(__ATOMIC_ACQUIRE, "agent");
            asm volatile("s_waitcnt vmcnt(0)" ::: "memory");
        }
    }
    __syncthreads();
}

__device__ __forceinline__ void attn_phase(char* lds, const attn_body::bf16* P, attn_body::bf16* O, const float* sink, float* ssq, const float* gq, const float* gk, int vcu, int G, int tid_in) {
    bool nomax;
    { int ln_ = tid_in & 63; float a = __builtin_fabsf(gq[ln_]), b = __builtin_fabsf(gk[ln_]);
#pragma unroll
      for (int o = 1; o < 64; o <<= 1) { a = __builtin_fmaxf(a, __shfl_xor(a, o)); b = __builtin_fmaxf(b, __shfl_xor(b, o)); }
      const float B2 = 64.f * a * b * attn_body::C2; nomax = __builtin_amdgcn_readfirstlane((int)(B2 < 96.f)) != 0; }
    for (int L = vcu; L < 3072; L += G) {
        int mode, S, rowbase, q0, hq;
        if (L < 1536) {
            mode = 0; int b, hkv, g, qb;
            if (L < 1024) { const int i = L >> 8, v = L & 255, x = v >> 5, c = v & 31, u = 128 * (x & 1) + i * 32 + c, combo = x >> 1; b = combo >> 1; hkv = combo & 1; g = u >> 6; qb = u & 63; S = S_P; rowbase = b * S_P; }
            else { const int Ls = L - 1024, i = Ls >> 8, v = Ls & 255, x = v >> 5, c = v & 31, u = 64 * (x & 1) + i * 32 + c, combo = x >> 1; b = combo >> 1; hkv = combo & 1; g = u >> 5; qb = u & 31; S = S_S; rowbase = M_P + b * S_S; }
            hq = hkv * 4 + g; q0 = qb * 256;
        } else {
            mode = 1; const int Lw = L - 1536; hq = Lw & 7; const int row0 = (Lw >> 3) * 256;
            if (row0 < M_P) { S = S_P; rowbase = row0 & ~(S_P - 1); } else { S = S_S; rowbase = M_P + ((row0 - M_P) & ~(S_S - 1)); }
            q0 = row0 - rowbase;
        }
        const attn_body::bf16* Q = P + (size_t)rowbase * NIN + mode * 768 + hq * 64;
        const attn_body::bf16* K = P + (size_t)rowbase * NIN + mode * 768 + 512 + (hq >> 2) * 64;
        const attn_body::bf16* V = K + 128;
        attn_body::bf16* Oo = O + (size_t)rowbase * DM + mode * 512 + hq * 64; float* sq = ssq + (size_t)rowbase * 16 + mode * 8 + hq;
        if (mode == 0) { if (nomax) attn_body::attn_unit<0, 8, true>(Q, K, V, Oo, S, q0, 0.f, 0.f, sq, lds, tid_in); else attn_body::attn_unit<0, 8, false>(Q, K, V, Oo, S, q0, 0.f, 0.f, sq, lds, tid_in); }
        else { const float sink2 = sink[hq] * LOG2E; const float slope2 = __builtin_amdgcn_exp2f(-(float)(hq + 1)) * LOG2E; attn_body::attn_unit<1, 8, false>(Q, K, V, Oo, S, q0, sink2, slope2, sq, lds, tid_in); }
    }
}

struct Args { const float* in[21]; float* out; unsigned char* ws; };
__global__ void __launch_bounds__(NWAVES * 64, 2) mega_fwd(Args args) {
    extern __shared__ __attribute__((aligned(16))) unsigned char lds[];
    cg::grid_group grid = cg::this_grid();
    const int wave = __builtin_amdgcn_readfirstlane((int)threadIdx.x >> 6);
#define lane ({ int l_ = (int)__builtin_amdgcn_mbcnt_hi(~0u, __builtin_amdgcn_mbcnt_lo(~0u, 0u)); asm volatile("" : "+v"(l_)); l_; })
#define MYTID() ((wave << 6) | lane)
    const int G = gridDim.x; const int bx = blockIdx.x; const int vcu = (G % 8 == 0) ? (bx % 8) * (G / 8) + bx / 8 : bx;
    const int gw = vcu * NWAVES + wave, NGW = G * NWAVES;
    typedef const __attribute__((address_space(4))) Args* kargp_t;
    kargp_t kap = (kargp_t)__builtin_amdgcn_kernarg_segment_ptr();
#define KARG() ({ kargp_t p_ = kap; asm volatile("" : "+s"(p_)); p_; })
#define INP(i) (KARG()->in[i])
#define ws (KARG()->ws)
#define xout (KARG()->out)
#define XB ((bfu*)(ws + WS_ACT))
#define HB ((bfu*)(ws + WS_BIG))
#define PB ((bfu*)(ws + WS_BIG))
#define OB ((bfu*)(ws + WS_O))
#define RSX ((float*)(ws + WS_RSX))
#define SSQ ((float*)(ws + WS_SSQ))
#define YB ((bfu*)xout)
    LAS unsigned char* ldsp = (LAS unsigned char*)lds;
    if (MYTID() < 32) ((LAS unsigned*)(ldsp + MISC_OFF))[MYTID()] = 0u;
    __syncthreads();
    XcdBarrier xbar = xcd_barrier_post((unsigned*)(ws + WS_CTL), (volatile LAS unsigned*)(ldsp + MISC_OFF) + 8, MYTID() == 0);

    PH(0) for (int rp = 0; rp < REP_PRO; ++rp) {
        constexpr int I_G = (DM / 64) * (DFF / 32), I_D = (DFF / 64) * (DM / 32), I_I = (DM / 64) * (NIN / 32), I_O = (DM / 64) * (DM / 32);
        constexpr int PER_LAYER = 4 * I_G + 2 * I_D + I_I + I_O, NITEMS = DEPTH * PER_LAYER;
#define TI_DECODE(d, it_) do { const int l_ = (it_) / PER_LAYER; int r = (it_) % PER_LAYER; unsigned char* wl_ = ws + (size_t)l_ * W_LAYER; \
            if (r < I_G) { d = TiDesc{INP(4) + (size_t)l_ * DM * DFF, (bfu*)(wl_ + W_GU1), INP(2) + l_ * DM, nullptr, DM, DFF, 1, r}; break; } r -= I_G; \
            if (r < I_G) { d = TiDesc{INP(5) + (size_t)l_ * DM * DFF, (bfu*)(wl_ + W_GU1), INP(2) + l_ * DM, nullptr, DM, DFF, 2, r}; break; } r -= I_G; \
            if (r < I_D) { d = TiDesc{INP(6) + (size_t)l_ * DM * DFF, (bfu*)(wl_ + W_D1), nullptr, nullptr, DFF, DM, 0, r}; break; } r -= I_D; \
            if (r < I_I) { d = TiDesc{INP(9) + (size_t)l_ * DM * NIN, (bfu*)(wl_ + W_IN), INP(7) + l_ * DM, nullptr, DM, NIN, 3, r}; break; } r -= I_I; \
            if (r < I_O) { d = TiDesc{INP(15) + (size_t)l_ * DM * DM, (bfu*)(wl_ + W_OUT), INP(13) + l_ * 512, INP(14) + l_ * 512, DM, DM, 0, r}; break; } r -= I_O; \
            if (r < I_G) { d = TiDesc{INP(18) + (size_t)l_ * DM * DFF, (bfu*)(wl_ + W_GU2), INP(16) + l_ * DM, nullptr, DM, DFF, 1, r}; break; } r -= I_G; \
            if (r < I_G) { d = TiDesc{INP(19) + (size_t)l_ * DM * DFF, (bfu*)(wl_ + W_GU2), INP(16) + l_ * DM, nullptr, DM, DFF, 2, r}; break; } r -= I_G; \
            d = TiDesc{INP(20) + (size_t)l_ * DM * DFF, (bfu*)(wl_ + W_D2), nullptr, nullptr, DFF, DM, 0, r}; } while (0)
        const int ln = lane;
        for (int it = gw; it < NITEMS; it += 2 * NGW) {
            TiDesc da, db; f32x4 va[8], vb[8], ga[2], gb[2]; size_t dsta, dstb = 0; const bool two = (it + NGW) < NITEMS;
            TI_DECODE(da, it); ti_load(da, ln, va, ga, dsta);
            if (two) { TI_DECODE(db, it + NGW); ti_load(db, ln, vb, gb, dstb); }
            ti_store(da, va, ga, dsta);
            if (two) ti_store(db, vb, gb, dstb);
        }
#undef TI_DECODE
        for (int m = 4 * lsg(gw); m < M; m += 4 * lsg(NGW)) { const float* xr = (m < M_P) ? INP(0) + (size_t)m * DM : INP(1) + (size_t)(m - M_P) * DM; e_first_rows4(xr, XB + (size_t)m * DM, RSX + m, lane); }
    }
    grid.sync();

#define GEMM_SWIGLU(WOFF) do { pg8::Gemm g{XB, (const bfu*)(wl + (WOFF)), M, 2 * DFF, DM}; pg8::StaticOrder S; S.init(M, 2 * DFF, lsg(G), lsg(bx), HALF_TAIL_GU); pg8::EpiSwiGLU E{HB, DFF, RSX}; \
        pg8::gemm_phase<pg8::EpiSwiGLU, pg8::StaticOrder, SWIGLU_ALIGN, GEMM_SP2>(ldsp, g, S, E, MYTID()); } while (0)
#ifndef DOWN_REV
#define DOWN_REV true
#endif
#define GEMM_PLAIN(A_, WOFF, N_, K_, O_, LDC) do { pg8::Gemm g{(A_), (const bfu*)(wl + (WOFF)), M, (N_), (K_)}; pg8::StaticOrder S; S.init(M, (N_), lsg(G), lsg(bx), false, DOWN_REV); pg8::EpiPlain E{(O_), (LDC), 0, 0, 1.0f}; \
        pg8::gemm_phase<pg8::EpiPlain, pg8::StaticOrder, true, GEMM_SP2>(ldsp, g, S, E, MYTID()); } while (0)
#define GEMM_WIN() do { pg8::Gemm g{XB, (const bfu*)(wl + W_IN), M, NIN, DM}; pg8::StaticOrder S; S.init(M, NIN, lsg(G), lsg(bx)); pg8::EpiWin E{PB, RSX, INP(10) + l * 64, INP(11) + l * 64, attn_body::C2}; \
        pg8::gemm_phase<pg8::EpiWin, pg8::StaticOrder, true, GEMM_SP2>(ldsp, g, S, E, MYTID()); } while (0)
#define GEMM_WOUT() do { pg8::Gemm g{OB, (const bfu*)(wl + W_OUT), M, DM, DM}; pg8::StaticOrder S; S.init(M, DM, lsg(G), lsg(bx)); pg8::EpiOutNorm E{YB, YLD, SSQ}; \
        pg8::gemm_phase<pg8::EpiOutNorm, pg8::StaticOrder, true, GEMM_SP2>(ldsp, g, S, E, MYTID()); } while (0)
#ifndef EP_ROWS
#define EP_ROWS 4
#endif
#define E_POST(GP, SCALE, FINAL) do { for (int rp = 0; rp < ((FINAL) ? 1 : REP_EPOST); ++rp) for (int m = EP_ROWS * lsg(gw); m < M; m += EP_ROWS * lsg(NGW)) \
        e_post_rows<FINAL, EP_ROWS>(YB + (size_t)m * YLD, XB + (size_t)m * DM, RSX + m, xout + (size_t)m * DM, (GP), rp == 0 ? (SCALE) : 0.0f, lane); } while (0)

#pragma nounroll
    for (int l = 0; l < DEPTH; ++l) {
#define wl (ws + (size_t)l * W_LAYER)
        PH(1) for (int rp = 0; rp < REP_GU; ++rp) GEMM_SWIGLU(W_GU1);
        GSYNC();
        PH(2) for (int rp = 0; rp < REP_DN; ++rp) GEMM_PLAIN(HB, W_D1, DM, DFF, YB, YLD);
        GSYNC();
        PH(3) E_POST(INP(3) + l * DM, 0.5f, false);
        GSYNC();
        PH(4) for (int rp = 0; rp < REP_GEMM; ++rp) GEMM_WIN();
        GSYNC();
        PH(6) for (int rp = 0; rp < REP_ATTN; ++rp) attn_phase((char*)lds, (const attn_body::bf16*)PB, (attn_body::bf16*)OB, INP(12) + l * 8, SSQ, INP(10) + l * 64, INP(11) + l * 64, lsg(vcu), lsg(G), MYTID());
        GSYNC();
        PH(8) for (int rp = 0; rp < REP_GEMM; ++rp) GEMM_WOUT();
        GSYNC();
        PH(9) E_POST(INP(8) + l * DM, 1.0f, false);
        GSYNC();
        PH(10) for (int rp = 0; rp < REP_GU; ++rp) GEMM_SWIGLU(W_GU2);
        GSYNC();
        PH(11) for (int rp = 0; rp < REP_DN; ++rp) GEMM_PLAIN(HB, W_D2, DM, DFF, YB, YLD);
        GSYNC();
        if (l + 1 < DEPTH) { PH(12) E_POST(INP(17) + l * DM, 0.5f, false); GSYNC(); }
        else { PH(12) E_POST(INP(17) + l * DM, 0.5f, true); }
    }
}

#undef ws
#undef xout
#undef XB
#undef HB
#undef PB
#undef OB
#undef RSX
#undef SSQ
#undef YB
#undef wl
#undef lane
#undef MYTID
extern "C" void kernel_launch(void* const* d_in, const int* in_sizes, int n_in, void* d_out, int out_size, void* d_ws, size_t ws_size, hipStream_t stream) {
    static int grid = 0;
    if (grid == 0) {
        if (n_in != 21 || out_size != M * DM || ws_size < WS_END) { fprintf(stderr, "kernel_launch: unexpected shapes (n_in %d out %d ws %zu)\n", n_in, out_size, ws_size); grid = -1; return; }
        int dev = 0, cus = 0, per_cu = 0;
        hipGetDevice(&dev); hipDeviceGetAttribute(&cus, hipDeviceAttributeMultiprocessorCount, dev);
        hipFuncSetAttribute((const void*)mega_fwd, hipFuncAttributeMaxDynamicSharedMemorySize, LDS_BYTES);
        if (hipOccupancyMaxActiveBlocksPerMultiprocessor(&per_cu, (const void*)mega_fwd, NWAVES * 64, LDS_BYTES) != hipSuccess || per_cu < 1) per_cu = 1;
        (void)hipGetLastError();
        grid = cus * per_cu;
    }
    if (grid < 0) return;
    if (hipMemsetAsync((char*)d_ws + WS_CTL, 0, CTL_BYTES, stream) != hipSuccess) { fprintf(stderr, "kernel_launch: memset of the barrier words failed\n"); return; }
    Args a{};
    for (int i = 0; i < 21; ++i) a.in[i] = (const float*)d_in[i];
    a.out = (float*)d_out; a.ws = (unsigned char*)d_ws;
    void* kargs[] = {&a};
    hipError_t e = hipLaunchCooperativeKernel((const void*)mega_fwd, dim3(grid), dim3(NWAVES * 64), kargs, LDS_BYTES, stream);
    if (e != hipSuccess) fprintf(stderr, "cooperative launch failed: %s (grid %d)\n", hipGetErrorString(e), grid);
}
```

```cpp
#include <hip/hip_runtime.h>
#include <cstdio>
#include <cstdint>
#ifndef PG8_WGM
#define PG8_WGM 8
#endif
namespace pg8 {
#define PG8_LAS __attribute__((address_space(3)))
typedef unsigned short bf16_t;
typedef short bf16x8 __attribute__((ext_vector_type(8)));
typedef float f32x4 __attribute__((ext_vector_type(4)));
typedef unsigned u32x4 __attribute__((ext_vector_type(4)));
constexpr int BM = 256, BK = 64, HALF = 128, HTB = HALF * BK * 2  , STAGE_BYTES = 8 * HTB, NXCD = 8, WGM = PG8_WGM;

__host__ __device__ __forceinline__ int lds_byte(int r, int c) { const int st = (r >> 4) * 2 + (c >> 5), rr = r & 15, cc = c & 31, ob = rr * 64 + cc * 2; return st * 1024 + (ob ^ (((ob >> 9) & 1) << 5)); }
__host__ __device__ __forceinline__ void stage_rc(int b, int& R, int& C) { const int st = b / 1024, sb = b % 1024, swz = sb ^ (((sb >> 9) & 1) << 5); R = (st >> 1) * 16 + swz / 64; C = (st & 1) * 32 + (swz % 64) / 2; }
__host__ __device__ __forceinline__ int perm32(int rho) { const int n = rho >> 4, i = rho & 15; return 8 * (i >> 2) + 4 * n + (i & 3); }

struct Unit { int pm, pn; };
struct Gemm { const bf16_t* A; const bf16_t* Bt; int M, N, K; };

struct StaticOrder {
    int nM, nN, nwg, G, c, nfull, rev;
    __host__ __device__ void init(int M, int N, int G_, int c_, bool half_tail = false, bool rev_ = false) { nM = M / BM; nN = N / BM; nwg = nM * nN; G = G_; c = c_; nfull = nwg; rev = rev_ ? 1 : 0;
        if (half_tail) { const int f = (nwg / G) * G; if ((G & 1) == 0 && (nwg - f) * 2 == G) nfull = f; } }
    __host__ __device__ void map(int L, Unit& u) const {
        int wgid = L; { const int q = nwg / NXCD, r = nwg % NXCD, xcd = wgid % NXCD, off = wgid / NXCD; wgid = (xcd < r ? xcd * (q + 1) : r * (q + 1) + (xcd - r) * q) + off; }
        const int nig = WGM * nN, gid = wgid / nig, fm = gid * WGM, gsz = (nM - fm) < WGM ? (nM - fm) : WGM;
        u.pm = fm + ((wgid % nig) % gsz); u.pn = (wgid % nig) / gsz; if (rev) u.pm = nM - 1 - u.pm; }
    __host__ __device__ bool half_unit(Unit& u, int& h) const { if (nfull == nwg) return false; map(nfull + (c >> 1), u); h = c & 1; return true; }
    __host__ __device__ bool next(int i, Unit& u) const {
        const long L = (long)i * G + c; if (L >= nfull) return false;
        map((int)L, u); return true;
    }
    __device__ __forceinline__ void a_ready(const Unit&) const {}
    __device__ __forceinline__ void done(const Unit&) const {}
};

__device__ __forceinline__ unsigned cvt_pk_bf16(float lo, float hi) { unsigned r; asm volatile("v_cvt_pk_bf16_f32 %0, %1, %2" : "=v"(r) : "v"(lo), "v"(hi)); return r; }
__device__ __forceinline__ float silu_mul(float g, float u, float c1, float c2) { const float e = __builtin_amdgcn_exp2f(g * c1); return (g * u) * (c2 * __builtin_amdgcn_rcpf(1.0f + e)); }
struct EpiSwiGLU {
    static constexpr bool PERM = true, AFTER_DRAIN = false, MIDSCALE = false, PREFETCH = false, HALF_TAIL = false;
    __device__ __forceinline__ void half(const f32x4 (&acc)[2][2][4][2], const Unit& u, int hh, int wr, int wc, int fr, int fq) const {
        unsigned lrow = (unsigned)(hh * HALF + wr * 64 + fr); asm volatile("" : "+v"(lrow)); const float* rb = rsx + u.pm * BM;
        bf16_t* obase = O + (size_t)u.pm * BM * ldc + u.pn * HALF + wc * 32 + 8 * fq;
#pragma unroll
        for (int m = 0; m < 4; ++m) { const unsigned lr = lrow + (unsigned)(m * 16); const float rs = rb[lr], c1 = rs * -1.4426950408889634f, c2 = rs * rs;
            const f32x4 g0 = acc[0][0][m][0], g1 = acc[0][0][m][1], u0 = acc[0][1][m][0], u1 = acc[0][1][m][1];
            u32x4 w; w.x = cvt_pk_bf16(silu_mul(g0[0], u0[0], c1, c2), silu_mul(g0[1], u0[1], c1, c2)); w.y = cvt_pk_bf16(silu_mul(g0[2], u0[2], c1, c2), silu_mul(g0[3], u0[3], c1, c2));
            w.z = cvt_pk_bf16(silu_mul(g1[0], u1[0], c1, c2), silu_mul(g1[1], u1[1], c1, c2)); w.w = cvt_pk_bf16(silu_mul(g1[2], u1[2], c1, c2), silu_mul(g1[3], u1[3], c1, c2));
            *(u32x4*)(obase + (size_t)lr * ldc) = w; }
    }
    bf16_t* O; int ldc; const float* rsx;
    __device__ __forceinline__ void prefetch(const Unit& u, int wr, int fr, float (&rsv)[2][4]) const {
        unsigned lrow = (unsigned)(wr * 64 + fr); asm volatile("" : "+v"(lrow)); const float* rb = rsx + u.pm * BM;
#pragma unroll
        for (int ai = 0; ai < 2; ++ai)
#pragma unroll
            for (int m = 0; m < 4; ++m) rsv[ai][m] = rb[lrow + (unsigned)(ai * HALF + m * 16)];
    }
    __device__ __forceinline__ void operator()(const f32x4 (&acc)[2][2][4][2], const Unit& u, int wr, int wc, int fr, int fq) const {
        const int row0 = u.pm * BM + wr * 64 + fr; const int col0 = u.pn * HALF + wc * 32 + 8 * fq;
        float rsv[2][4]; prefetch(u, wr, fr, rsv);
#pragma unroll
        for (int ai = 0; ai < 2; ++ai)
#pragma unroll
            for (int m = 0; m < 4; ++m) { bf16_t* rowp = O + (size_t)(row0 + ai * HALF + m * 16) * ldc + col0;
                const float rs = rsv[ai][m], c1 = rs * -1.4426950408889634f, c2 = rs * rs; const f32x4 g0 = acc[ai][0][m][0], g1 = acc[ai][0][m][1], u0 = acc[ai][1][m][0], u1 = acc[ai][1][m][1];
                u32x4 w; w.x = cvt_pk_bf16(silu_mul(g0[0], u0[0], c1, c2), silu_mul(g0[1], u0[1], c1, c2)); w.y = cvt_pk_bf16(silu_mul(g0[2], u0[2], c1, c2), silu_mul(g0[3], u0[3], c1, c2));
                w.z = cvt_pk_bf16(silu_mul(g1[0], u1[0], c1, c2), silu_mul(g1[1], u1[1], c1, c2)); w.w = cvt_pk_bf16(silu_mul(g1[2], u1[2], c1, c2), silu_mul(g1[3], u1[3], c1, c2));
                *(u32x4*)rowp = w; }
    }
};
struct EpiPlain {
    static constexpr bool PERM = true, AFTER_DRAIN = false, MIDSCALE = false, PREFETCH = false, HALF_TAIL = false;
    bf16_t* O; int ldc; int sc_lo, sc_hi; float scv;
    __device__ __forceinline__ void operator()(const f32x4 (&acc)[2][2][4][2], const Unit& u, int wr, int wc, int fr, int fq) const {
        const int row0 = u.pm * BM + wr * 64 + fr; const int col0 = u.pn * BM + wc * 32 + 8 * fq;
        const float sc = (u.pn >= sc_lo && u.pn < sc_hi) ? scv : 1.0f;
#pragma unroll
        for (int ai = 0; ai < 2; ++ai)
#pragma unroll
            for (int m = 0; m < 4; ++m) { bf16_t* rowp = O + (size_t)(row0 + ai * HALF + m * 16) * ldc + col0;
#pragma unroll
                for (int bj = 0; bj < 2; ++bj) { const f32x4 v0 = acc[ai][bj][m][0] * sc, v1 = acc[ai][bj][m][1] * sc;
                    u32x4 w; w.x = cvt_pk_bf16(v0[0], v0[1]); w.y = cvt_pk_bf16(v0[2], v0[3]); w.z = cvt_pk_bf16(v1[0], v1[1]); w.w = cvt_pk_bf16(v1[2], v1[3]);
                    *(u32x4*)(rowp + bj * HALF) = w; } }
    }
};


struct EpiWin {
    static constexpr bool PERM = true, AFTER_DRAIN = false, MIDSCALE = false, PREFETCH = false, HALF_TAIL = false;
    bf16_t* O; const float* rsx; const float* gq; const float* gk; float qscale;
    __device__ __forceinline__ void operator()(const f32x4 (&acc)[2][2][4][2], const Unit& u, int wr, int wc, int fr, int fq) const {
        const int hc = u.pn * BM + wc * 64;
        unsigned lrow = (unsigned)(wr * 64 + fr); asm volatile("" : "+v"(lrow));
        unsigned loff = lrow * 1536u + (unsigned)(wc * 64 + 8 * fq);
        bf16_t* obase = O + (size_t)u.pm * BM * 1536 + u.pn * BM;
        const float* rbase = rsx + u.pm * BM; const int trow0 = u.pm * BM;
        if (hc < 640) {
            const float* gp = (hc < 512) ? gq : gk; const float osc = (hc < 512) ? qscale : 1.0f;
            f32x4 gg[2][2]; float invf[2][2];
#pragma unroll
            for (int bj = 0; bj < 2; ++bj)
#pragma unroll
                for (int n = 0; n < 2; ++n) gg[bj][n] = *(const f32x4*)(gp + 32 * bj + 8 * fq + 4 * n);
#pragma unroll
            for (int n = 0; n < 2; ++n)
#pragma unroll
                for (int jj = 0; jj < 2; ++jj) invf[n][jj] = __builtin_amdgcn_exp2f((float)(4 * fq + 2 * n + jj) * -0.83048202372184058696f) * 0.15915494309189533577f;
#pragma unroll
            for (int ai = 0; ai < 2; ++ai)
#pragma unroll
                for (int m = 0; m < 4; ++m) {
                    const unsigned lr = lrow + (unsigned)(ai * HALF + m * 16); const int row = trow0 + (int)lr; const int t = (row < 32768) ? (row & 16383) : (row & 8191);
                    const float rs = rbase[lr]; float pos[2]; pos[0] = (float)(t >> 6); pos[1] = (float)(t & 63);
                    f32x4 v[2][2]; float ss = 0.f;
#pragma unroll
                    for (int bj = 0; bj < 2; ++bj)
#pragma unroll
                        for (int n = 0; n < 2; ++n) { v[bj][n] = acc[ai][bj][m][n] * rs; ss += (v[bj][n][0] * v[bj][n][0] + v[bj][n][1] * v[bj][n][1]) + (v[bj][n][2] * v[bj][n][2] + v[bj][n][3] * v[bj][n][3]); }
                    ss += __shfl_xor(ss, 16); ss += __shfl_xor(ss, 32);
                    const float rstd = __builtin_amdgcn_rsqf(ss * (1.0f / 64.0f) + 1e-6f);
#pragma unroll
                    for (int bj = 0; bj < 2; ++bj) { float o[8];
#pragma unroll
                        for (int n = 0; n < 2; ++n) { const f32x4 x = v[bj][n] * rstd * gg[bj][n];
#pragma unroll
                            for (int jj = 0; jj < 2; ++jj) { float rev = pos[bj] * invf[n][jj]; rev = rev - __builtin_floorf(rev);
                                const float sn = __builtin_amdgcn_sinf(rev), cs = __builtin_amdgcn_cosf(rev); const float x0 = x[2 * jj], x1 = x[2 * jj + 1];
                                o[4 * n + 2 * jj] = (x0 * cs - x1 * sn) * osc; o[4 * n + 2 * jj + 1] = (x0 * sn + x1 * cs) * osc; } }
                        u32x4 w; w.x = cvt_pk_bf16(o[0], o[1]); w.y = cvt_pk_bf16(o[2], o[3]); w.z = cvt_pk_bf16(o[4], o[5]); w.w = cvt_pk_bf16(o[6], o[7]);
                        *(u32x4*)(obase + (loff + (unsigned)((ai * HALF + m * 16) * 1536 + 32 * bj))) = w; }
                    asm volatile("" ::: "memory"); __builtin_amdgcn_sched_barrier(0);
                }
        } else {
            const float sc = (hc >= 768 && hc < 1280) ? qscale : 1.0f;
#pragma unroll
            for (int ai = 0; ai < 2; ++ai)
#pragma unroll
                for (int m = 0; m < 4; ++m) { const unsigned lr = lrow + (unsigned)(ai * HALF + m * 16); const float rs = rbase[lr] * sc;
#pragma unroll
                    for (int bj = 0; bj < 2; ++bj) { const f32x4 v0 = acc[ai][bj][m][0] * rs, v1 = acc[ai][bj][m][1] * rs;
                        u32x4 w; w.x = cvt_pk_bf16(v0[0], v0[1]); w.y = cvt_pk_bf16(v0[2], v0[3]); w.z = cvt_pk_bf16(v1[0], v1[1]); w.w = cvt_pk_bf16(v1[2], v1[3]);
                        *(u32x4*)(obase + (loff + (unsigned)((ai * HALF + m * 16) * 1536 + 32 * bj))) = w; } }
        }
    }
};


struct EpiOutNorm {
    static constexpr bool PERM = true, AFTER_DRAIN = false, MIDSCALE = true, PREFETCH = false, HALF_TAIL = false;
    bf16_t* O; int ldc; const float* ssq;
    __device__ __forceinline__ void mid(f32x4 (&acc)[2][2][4][2], const Unit& u, int wr, int fr, float (&rbv)[2][4]) const {
        unsigned lrow = (unsigned)(wr * 64 + fr); asm volatile("" : "+v"(lrow));
        const float* sb = ssq + (size_t)u.pm * BM * 16;
#pragma unroll
        for (int ai = 0; ai < 2; ++ai)
#pragma unroll
            for (int m = 0; m < 4; ++m) { const f32x4* p = (const f32x4*)(sb + (lrow + (unsigned)(ai * HALF + m * 16)) * 16u);
                const f32x4 a0 = p[0], a1 = p[1], b0 = p[2], b1 = p[3];
                const float sa = ((a0[0] + a0[1]) + (a0[2] + a0[3])) + ((a1[0] + a1[1]) + (a1[2] + a1[3])), sb2 = ((b0[0] + b0[1]) + (b0[2] + b0[3])) + ((b1[0] + b1[1]) + (b1[2] + b1[3]));
                const float ra = __builtin_amdgcn_rsqf(sa * (1.0f / 512.0f) + 1e-6f), rb = __builtin_amdgcn_rsqf(sb2 * (1.0f / 512.0f) + 1e-6f);
                rbv[ai][m] = rb; const float ratio = ra * __builtin_amdgcn_rcpf(rb);
#pragma unroll
                for (int bj = 0; bj < 2; ++bj)
#pragma unroll
                    for (int n = 0; n < 2; ++n) acc[ai][bj][m][n] = acc[ai][bj][m][n] * ratio; }
    }
    __device__ __forceinline__ void operator()(const f32x4 (&acc)[2][2][4][2], const Unit& u, int wr, int wc, int fr, int fq, const float (&rbv)[2][4]) const {
        const int row0 = u.pm * BM + wr * 64 + fr; const int col0 = u.pn * BM + wc * 32 + 8 * fq;
#pragma unroll
        for (int ai = 0; ai < 2; ++ai)
#pragma unroll
            for (int m = 0; m < 4; ++m) { bf16_t* rowp = O + (size_t)(row0 + ai * HALF + m * 16) * ldc + col0; const float sc = rbv[ai][m];
#pragma unroll
                for (int bj = 0; bj < 2; ++bj) { const f32x4 v0 = acc[ai][bj][m][0] * sc, v1 = acc[ai][bj][m][1] * sc;
                    u32x4 w; w.x = cvt_pk_bf16(v0[0], v0[1]); w.y = cvt_pk_bf16(v0[2], v0[3]); w.z = cvt_pk_bf16(v1[0], v1[1]); w.w = cvt_pk_bf16(v1[2], v1[3]);
                    *(u32x4*)(rowp + bj * HALF) = w; } }
    }
};

template <class Epi, class Sched, bool ALIGN_EPI = false, bool SP2 = false>
__device__ __forceinline__ void gemm_phase(PG8_LAS unsigned char* lds, const Gemm g, const Sched& S, const Epi& E, int tid_in) {
    int tid_ = tid_in; asm volatile("" : "+v"(tid_)); const int tid = tid_, wid = __builtin_amdgcn_readfirstlane(tid >> 6), lane = tid & 63, wr = wid >> 2, wc = wid & 3, fr = lane & 15, fq = lane >> 4;
    const int K = g.K, nt = K / BK;
    unsigned voffA[2], voffB[2];
#pragma unroll
    for (int i = 0; i < 2; ++i) { int R, C; stage_rc(tid * 16 + i * 8192, R, C); const int Rb = Epi::PERM ? ((R & ~31) + perm32(R & 31)) : R;
        voffA[i] = (unsigned)(R * K + C) * 2u; voffB[i] = (unsigned)(Rb * K + C) * 2u; }
    const size_t kstep = (size_t)(BK * 2);
    const size_t hstep = (size_t)HALF * K * 2;
    const size_t tstep = 2 * hstep;
    const unsigned ldsw = (unsigned)wid * 1024u;
    const int aoff = lds_byte(wr * 64 + fr, fq * 8), boff = lds_byte(wc * 32 + fr, fq * 8);
#define PG8_SA(b, h) (((b) * 2 + (h)) * HTB)
#define PG8_SB(b, h) ((4 + (b) * 2 + (h)) * HTB)
#define PG8_STAGE(bufoff, gbase, voff) do { _Pragma("unroll") for (int _i = 0; _i < 2; ++_i) \
        __builtin_amdgcn_global_load_lds((const unsigned*)((const char*)(gbase) + (voff)[_i]), (PG8_LAS unsigned*)(lds + (bufoff) + ldsw + _i * 8192), 16, 0, 0); } while (0)
#define PG8_LDA(dst, b, h) do { _Pragma("unroll") for (int m = 0; m < 4; ++m) _Pragma("unroll") for (int k = 0; k < 2; ++k) dst[m][k] = *(const PG8_LAS bf16x8*)(lds + PG8_SA(b, h) + aoff + m * 2048 + k * 1024); } while (0)
#define PG8_LDB(dst, b, h) do { _Pragma("unroll") for (int n = 0; n < 2; ++n) _Pragma("unroll") for (int k = 0; k < 2; ++k) dst[n][k] = *(const PG8_LAS bf16x8*)(lds + PG8_SB(b, h) + boff + n * 2048 + k * 1024); } while (0)
#define PG8_MMA(ai, bj, At, Bt) do { __builtin_amdgcn_s_setprio(1); _Pragma("unroll") for (int m = 0; m < 4; ++m) _Pragma("unroll") for (int n = 0; n < 2; ++n) _Pragma("unroll") for (int k = 0; k < 2; ++k) \
        acc[ai][bj][m][n] = __builtin_amdgcn_mfma_f32_16x16x32_bf16(Bt[n][k], At[m][k], acc[ai][bj][m][n], 0, 0, 0); __builtin_amdgcn_s_setprio(0); } while (0)
#define PG8_WAIT_V(n) asm volatile("s_waitcnt vmcnt(" #n ")" ::: "memory")
#define PG8_WAIT_L(n) asm volatile("s_waitcnt lgkmcnt(" #n ")" ::: "memory")
#define PG8_BAR __builtin_amdgcn_s_barrier()
#define PG8_SCHED __builtin_amdgcn_sched_barrier(0)
    Unit cur, nxt; int ui = 0;
    if (!S.next(0, cur)) return;
    f32x4 acc[2][2][4][2]; float midst[2][4];
#pragma unroll
    for (int a = 0; a < 2; ++a)
#pragma unroll
        for (int b = 0; b < 2; ++b)
#pragma unroll
            for (int m = 0; m < 4; ++m)
#pragma unroll
                for (int n = 0; n < 2; ++n) acc[a][b][m][n] = (f32x4){0.f, 0.f, 0.f, 0.f};
    bf16x8 At[4][2], B0[2][2], B1[2][2];
    const char* cA = (const char*)g.A + (size_t)cur.pm * tstep; const char* cB = (const char*)g.Bt + (size_t)cur.pn * tstep;
    S.a_ready(cur);
    if constexpr (SP2) {
        PG8_STAGE(PG8_SB(0, 0), cB, voffB); PG8_STAGE(PG8_SB(0, 1), cB + hstep, voffB); PG8_STAGE(PG8_SA(0, 0), cA, voffA); PG8_STAGE(PG8_SA(0, 1), cA + hstep, voffA);
        if (wr == 1) PG8_BAR;
        PG8_WAIT_V(2); PG8_BAR;
        PG8_STAGE(PG8_SB(1, 0), cB + kstep, voffB); PG8_STAGE(PG8_SA(1, 0), cA + kstep, voffA); PG8_STAGE(PG8_SB(1, 1), cB + hstep + kstep, voffB);
        PG8_WAIT_V(6); PG8_BAR;
    } else {
        PG8_STAGE(PG8_SB(0, 0), cB, voffB); PG8_STAGE(PG8_SA(0, 0), cA, voffA); PG8_STAGE(PG8_SB(0, 1), cB + hstep, voffB); PG8_STAGE(PG8_SA(0, 1), cA + hstep, voffA);
        if (wr == 1) PG8_BAR;
        PG8_WAIT_V(4); PG8_BAR;
        PG8_STAGE(PG8_SB(1, 0), cB + kstep, voffB); PG8_STAGE(PG8_SA(1, 0), cA + kstep, voffA); PG8_STAGE(PG8_SB(1, 1), cB + hstep + kstep, voffB);
        PG8_WAIT_V(6); PG8_BAR;
    }
    for (;;) {
        const bool has_next = S.next(ui + 1, nxt);
        const char* nA = has_next ? (const char*)g.A + (size_t)nxt.pm * tstep : cA; const char* nB = has_next ? (const char*)g.Bt + (size_t)nxt.pn * tstep : cB;
        for (int t = 0; t < nt; t += 2) {
            if constexpr (Epi::MIDSCALE) { if (t == (nt >> 1)) E.mid(acc, cur, wr, fr, midst); }
            if constexpr (Epi::PREFETCH) { if (t == nt - 2) E.prefetch(cur, wr, fr, midst); }
            const bool last = (t == nt - 2);
            const char* a1 = cA + (size_t)(t + 1) * kstep;
            const char* a2 = last ? nA : cA + (size_t)(t + 2) * kstep; const char* b2 = last ? nB : cB + (size_t)(t + 2) * kstep;
            const char* a3 = a2 + kstep; const char* b3 = b2 + kstep;
            if (last && has_next) S.a_ready(nxt);
            if constexpr (SP2) {
            PG8_LDB(B0, 0, 0); PG8_LDB(B1, 0, 1); PG8_SCHED; PG8_LDA(At, 0, 0); PG8_STAGE(PG8_SA(1, 1), a1 + hstep, voffA);
            PG8_WAIT_V(8); PG8_WAIT_L(0); PG8_BAR; PG8_MMA(0, 0, At, B0); PG8_MMA(0, 1, At, B1); PG8_BAR; PG8_SCHED;
            PG8_LDA(At, 0, 1); PG8_STAGE(PG8_SB(0, 0), b2, voffB); PG8_STAGE(PG8_SB(0, 1), b2 + hstep, voffB); PG8_STAGE(PG8_SA(0, 0), a2, voffA);
            PG8_WAIT_V(8); PG8_WAIT_L(0); PG8_BAR; PG8_MMA(1, 0, At, B0); PG8_MMA(1, 1, At, B1); PG8_BAR; PG8_SCHED;
            PG8_LDB(B0, 1, 0); PG8_LDB(B1, 1, 1); PG8_SCHED; PG8_LDA(At, 1, 0); PG8_STAGE(PG8_SA(0, 1), a2 + hstep, voffA);
            PG8_WAIT_V(8); PG8_WAIT_L(0); PG8_BAR; PG8_MMA(0, 0, At, B0); PG8_MMA(0, 1, At, B1); PG8_BAR; PG8_SCHED;
            PG8_LDA(At, 1, 1); PG8_STAGE(PG8_SB(1, 0), b3, voffB); PG8_STAGE(PG8_SB(1, 1), b3 + hstep, voffB); PG8_STAGE(PG8_SA(1, 0), a3, voffA);
            PG8_WAIT_V(8); PG8_WAIT_L(0); PG8_BAR; PG8_MMA(1, 0, At, B0); PG8_MMA(1, 1, At, B1); PG8_BAR; PG8_SCHED;
            } else {
            PG8_LDB(B0, 0, 0); PG8_SCHED; PG8_LDA(At, 0, 0); PG8_STAGE(PG8_SA(1, 1), a1 + hstep, voffA);
            PG8_WAIT_L(8); PG8_BAR; PG8_WAIT_L(0); PG8_MMA(0, 0, At, B0); PG8_BAR; PG8_SCHED;
            PG8_LDB(B1, 0, 1); PG8_STAGE(PG8_SB(0, 0), b2, voffB);
            PG8_BAR; PG8_WAIT_L(0); PG8_MMA(0, 1, At, B1); PG8_BAR;
            PG8_LDA(At, 0, 1); PG8_STAGE(PG8_SA(0, 0), a2, voffA);
            PG8_BAR; PG8_WAIT_L(0); PG8_MMA(1, 0, At, B0); PG8_BAR; PG8_SCHED;
            PG8_STAGE(PG8_SB(0, 1), b2 + hstep, voffB);
            PG8_WAIT_V(6); PG8_BAR; PG8_MMA(1, 1, At, B1); PG8_BAR;
            PG8_LDB(B0, 1, 0); PG8_SCHED; PG8_LDA(At, 1, 0); PG8_STAGE(PG8_SA(0, 1), a2 + hstep, voffA);
            PG8_WAIT_L(8); PG8_BAR; PG8_WAIT_L(0); PG8_MMA(0, 0, At, B0); PG8_BAR; PG8_SCHED;
            PG8_LDB(B1, 1, 1); PG8_STAGE(PG8_SB(1, 0), b3, voffB);
            PG8_BAR; PG8_WAIT_L(0); PG8_MMA(0, 1, At, B1); PG8_BAR;
            PG8_LDA(At, 1, 1); PG8_STAGE(PG8_SA(1, 0), a3, voffA);
            PG8_BAR; PG8_WAIT_L(0); PG8_MMA(1, 0, At, B0); PG8_BAR; PG8_SCHED;
            PG8_STAGE(PG8_SB(1, 1), b3 + hstep, voffB);
            PG8_WAIT_V(6); PG8_BAR; PG8_MMA(1, 1, At, B1); PG8_BAR;
            }
        }
        if constexpr (ALIGN_EPI) { if (wr == 0) PG8_BAR; }
        if constexpr (!Epi::AFTER_DRAIN) { if constexpr (Epi::MIDSCALE || Epi::PREFETCH) E(acc, cur, wr, wc, fr, fq, midst); else E(acc, cur, wr, wc, fr, fq); S.done(cur); }
        if (!has_next) break;
#pragma unroll
        for (int a = 0; a < 2; ++a)
#pragma unroll
            for (int b = 0; b < 2; ++b)
#pragma unroll
                for (int m = 0; m < 4; ++m)
#pragma unroll
                    for (int n = 0; n < 2; ++n) acc[a][b][m][n] = (f32x4){0.f, 0.f, 0.f, 0.f};
        cur = nxt; cA = nA; cB = nB; ++ui;
        if constexpr (ALIGN_EPI) { if (wr == 1) PG8_BAR; }
    }
    PG8_WAIT_V(0);
    if constexpr (!ALIGN_EPI) { if (wr == 0) PG8_BAR; }
    PG8_BAR;
    if constexpr (Epi::AFTER_DRAIN) { E.fused(acc, cur, wr, wc, fr, fq, lds, wid, lane); S.done(cur); }
    if constexpr (Epi::HALF_TAIL) {
        Unit hu; int hh;
        if (S.half_unit(hu, hh)) {
            const char* hA = (const char*)g.A + (size_t)hu.pm * tstep + (size_t)hh * hstep; const char* hB = (const char*)g.Bt + (size_t)hu.pn * tstep;
#pragma unroll
            for (int b = 0; b < 2; ++b)
#pragma unroll
                for (int m = 0; m < 4; ++m)
#pragma unroll
                    for (int n = 0; n < 2; ++n) acc[0][b][m][n] = (f32x4){0.f, 0.f, 0.f, 0.f};
#define HS_STAGE(s_, kt_) do { const int so_ = (s_) * 3 * HTB; const size_t ko_ = (size_t)(kt_) * kstep; PG8_STAGE(so_, hA + ko_, voffA); PG8_STAGE(so_ + HTB, hB + ko_, voffB); PG8_STAGE(so_ + 2 * HTB, hB + hstep + ko_, voffB); } while (0)
            HS_STAGE(0, 0); HS_STAGE(1, 1);
            int st = 0;
            for (int t = 0; t < nt; ++t) {
                if (t + 1 < nt) PG8_WAIT_V(6); else PG8_WAIT_V(0);
                PG8_BAR;
                if (t + 2 < nt) { const int s2 = (st >= 1) ? st - 1 : 2; HS_STAGE(s2, t + 2); }
                const int so = st * 3 * HTB;
#pragma unroll
                for (int n = 0; n < 2; ++n)
#pragma unroll
                    for (int k = 0; k < 2; ++k) { B0[n][k] = *(const PG8_LAS bf16x8*)(lds + so + HTB + boff + n * 2048 + k * 1024); B1[n][k] = *(const PG8_LAS bf16x8*)(lds + so + 2 * HTB + boff + n * 2048 + k * 1024); }
#pragma unroll
                for (int m = 0; m < 4; ++m)
#pragma unroll
                    for (int k = 0; k < 2; ++k) At[m][k] = *(const PG8_LAS bf16x8*)(lds + so + aoff + m * 2048 + k * 1024);
                PG8_WAIT_L(0);
                PG8_MMA(0, 0, At, B0); PG8_MMA(0, 1, At, B1);
                st = (st == 2) ? 0 : st + 1;
            }
            PG8_BAR;
#undef HS_STAGE
            E.half(acc, hu, hh, wr, wc, fr, fq);
        }
    }
#undef PG8_SA
#undef PG8_SB
#undef PG8_STAGE
#undef PG8_LDA
#undef PG8_LDB
#undef PG8_MMA
#undef PG8_WAIT_V
#undef PG8_WAIT_L
#undef PG8_BAR
#undef PG8_SCHED
}
}

#ifndef PG8_SP2
#define PG8_SP2 true
#endif
#ifndef PG8_ALIGN
#define PG8_ALIGN true
#endif
#include <hip/hip_bf16.h>
#include <cmath>
namespace attn_body {
using bf16=__hip_bfloat16;
using bf16x8=__attribute__((ext_vector_type(8)))short;
using s16x4=__attribute__((ext_vector_type(4)))short;
using f32x16=__attribute__((ext_vector_type(16)))float;
using u32x4=__attribute__((ext_vector_type(4)))unsigned;
constexpr int D=64,PITCH=1536,OPITCH=1024;
constexpr int NW=8,QBLK=32,QB=QBLK*NW,KVBLK=64;
__device__ __forceinline__ int crow(int r,int hi){return (r&3)+8*(r>>2)+4*hi;}
#define SBAR() __builtin_amdgcn_sched_barrier(0)
__device__ __forceinline__ void cmask(f32x16&p0,f32x16&p1,int jb,int qrel,int hi){
  const float NEG=-INFINITY; int kb=64*jb+4*hi;
  #pragma unroll
  for(int r=0;r<16;++r){int kv=kb+(r&3)+8*(r>>2); if(kv>qrel)p0[r]=NEG; if(kv+32>qrel)p1[r]=NEG;}
}

__device__ __forceinline__ void wmask(f32x16&p0,f32x16&p1,float fb,float slope2){
  const float NEG=-INFINITY;
  #pragma unroll
  for(int r=0;r<16;++r){ const float c=(float)((r&3)+8*(r>>2)); const float a0=__builtin_fabsf(fb-c), a1=__builtin_fabsf(fb-c-32.f);
    p0[r]=(a0<=128.f)?(p0[r]-slope2*a0):NEG; p1[r]=(a1<=128.f)?(p1[r]-slope2*a1):NEG; }
}
constexpr int NSLOT=5, SLOTB=8192;
constexpr int LDS_K=0, LDS_V=NSLOT*SLOTB, LDS_WS=2*NSLOT*SLOTB, LDS_OST=LDS_WS+NW*64*4, LDS_BYTES=LDS_OST+NW*4096;
constexpr float C2=0.125f*1.4426950408889634f;
__device__ __forceinline__ void glds16(const void*gsrc,unsigned lds_dst){unsigned keep;
  asm volatile("s_mov_b32 %0, m0\n\ts_mov_b32 m0, %2\n\ts_nop 0\n\tglobal_load_lds_dwordx4 %1, off\n\ts_mov_b32 m0, %0":"=&s"(keep):"v"(gsrc),"s"(lds_dst):"memory");}
__device__ __forceinline__ float max3f(float a,float b,float c){float r;asm("v_max3_f32 %0, %1, %2, %3":"=v"(r):"v"(a),"v"(b),"v"(c));return r;}
__device__ __forceinline__ float max2f(float a,float b){float r;asm("v_max_f32_e32 %0, %1, %2":"=v"(r):"v"(a),"v"(b));return r;}
__device__ __forceinline__ float fadd_s(float a,float b){float r;asm("v_add_f32_e32 %0, %1, %2":"=v"(r):"v"(a),"v"(b));return r;}
__device__ __forceinline__ float fsub_s(float a,float b){float r;asm("v_sub_f32_e32 %0, %1, %2":"=v"(r):"v"(a),"v"(b));return r;}
typedef float f32x2_t __attribute__((ext_vector_type(2))); typedef __bf16 bf16x2_t __attribute__((ext_vector_type(2)));
__device__ __forceinline__ unsigned cvtpk_s(float lo,float hi){f32x2_t v={lo,hi};bf16x2_t b=__builtin_convertvector(v,bf16x2_t);return __builtin_bit_cast(unsigned,b);}
#define WAIT_BAR(N) asm volatile("s_waitcnt vmcnt(" #N ") lgkmcnt(0)\n\ts_barrier":::"memory")

__device__ __forceinline__ void qkt(f32x16&p0,f32x16&p1,const char*Kslot,const bf16x8*qr,const f32x16&negm,int r32,int hi){
  const char*kb=Kslot+hi*1024+r32*16;
  #pragma unroll
  for(int d0=0;d0<4;++d0){
    const bf16x8 b0=*reinterpret_cast<const bf16x8*>(kb+d0*2048);
    const bf16x8 b1=*reinterpret_cast<const bf16x8*>(kb+d0*2048+512);
    if(d0==0){p0=__builtin_amdgcn_mfma_f32_32x32x16_bf16(b0,qr[0],negm,0,0,0);p1=__builtin_amdgcn_mfma_f32_32x32x16_bf16(b1,qr[0],negm,0,0,0);}
    else{p0=__builtin_amdgcn_mfma_f32_32x32x16_bf16(b0,qr[d0],p0,0,0,0);p1=__builtin_amdgcn_mfma_f32_32x32x16_bf16(b1,qr[d0],p1,0,0,0);}}
}
typedef __attribute__((address_space(3))) const char* lds_cptr;
typedef short v4i16_t __attribute__((ext_vector_type(4)));
__device__ __forceinline__ void kload8(bf16x8*kf,lds_cptr kp){
  kf[0]=*(const __attribute__((address_space(3))) bf16x8*)(kp);      kf[1]=*(const __attribute__((address_space(3))) bf16x8*)(kp+512);
  kf[2]=*(const __attribute__((address_space(3))) bf16x8*)(kp+2048); kf[3]=*(const __attribute__((address_space(3))) bf16x8*)(kp+2560);
  kf[4]=*(const __attribute__((address_space(3))) bf16x8*)(kp+4096); kf[5]=*(const __attribute__((address_space(3))) bf16x8*)(kp+4608);
  kf[6]=*(const __attribute__((address_space(3))) bf16x8*)(kp+6144); kf[7]=*(const __attribute__((address_space(3))) bf16x8*)(kp+6656);
}
__device__ __forceinline__ void kload2(bf16x8*kf,lds_cptr kp,int j){ kf[2*j]=*(const __attribute__((address_space(3))) bf16x8*)(kp+j*2048); kf[2*j+1]=*(const __attribute__((address_space(3))) bf16x8*)(kp+j*2048+512); }
__device__ __forceinline__ s16x4 vtr(lds_cptr p){ return __builtin_bit_cast(s16x4,__builtin_amdgcn_ds_read_tr16_b64_v4i16((__attribute__((address_space(3))) v4i16_t*)p)); }
__device__ __forceinline__ float rowmax(const f32x16&p0,const f32x16&p1){
  float a=max3f(p0[0],p0[1],p1[0]),b=max3f(p0[2],p0[3],p1[1]);a=max3f(a,p1[2],p1[3]);
  #pragma unroll
  for(int r=4;r<16;r+=4){a=max3f(a,p0[r],p0[r+1]);b=max3f(b,p0[r+2],p0[r+3]);a=max3f(a,p1[r],p1[r+1]);b=max3f(b,p1[r+2],p1[r+3]);}
  const float m=max2f(a,b);
  auto rr=__builtin_amdgcn_permlane32_swap(__float_as_uint(m),__float_as_uint(m),false,false);
  return max2f(__uint_as_float(rr[0]),__uint_as_float(rr[1]));
}
__device__ __forceinline__ void pv(f32x16*o,int vb,bf16x8 pa0,bf16x8 pa1,bf16x8 pa2,bf16x8 pa3){
  #pragma unroll
  for(int d0=0;d0<2;++d0){s16x4 lo[4],hi[4];
    #pragma unroll
    for(int ks=0;ks<4;++ks){
      asm volatile("ds_read_b64_tr_b16 %0,%1 offset:%c2":"=&v"(lo[ks]):"v"(vb),"i"(d0*4096+ks*1024):"memory");
      asm volatile("ds_read_b64_tr_b16 %0,%1 offset:%c2":"=&v"(hi[ks]):"v"(vb),"i"(d0*4096+ks*1024+512):"memory");}
    asm volatile("s_waitcnt lgkmcnt(0)":::"memory");SBAR();
    #define PK(k) (bf16x8){lo[k][0],lo[k][1],lo[k][2],lo[k][3],hi[k][0],hi[k][1],hi[k][2],hi[k][3]}
    o[d0]=__builtin_amdgcn_mfma_f32_32x32x16_bf16(pa0,PK(0),o[d0],0,0,0);
    o[d0]=__builtin_amdgcn_mfma_f32_32x32x16_bf16(pa1,PK(1),o[d0],0,0,0);
    o[d0]=__builtin_amdgcn_mfma_f32_32x32x16_bf16(pa2,PK(2),o[d0],0,0,0);
    o[d0]=__builtin_amdgcn_mfma_f32_32x32x16_bf16(pa3,PK(3),o[d0],0,0,0);
    #undef PK
  }
}
#ifndef ATTN_STORE16
#define ATTN_STORE16(p,v) (*(u32x4*)(p)=(v))
#endif
template<int MODE,int THRL,bool NOMAX> __device__ __forceinline__ void attn_unit(const bf16*Qs,const bf16*__restrict__ Ks,const bf16*__restrict__ Vs,bf16*Os,int S,int q0,float sink2,float slope2,float*ssq,char*shm,int tid_in){
  int tid_=tid_in; asm volatile("":"+v"(tid_)); const int tid=tid_,lane=tid&63,r32=lane&31,hi=lane>>5; const int wid=__builtin_amdgcn_readfirstlane(tid>>6);
  int kt0=0,kend=S/KVBLK;
  if(MODE==1){ kt0=(q0>=128?(q0-128):0)/KVBLK; const int ke=q0+QB+128; kend=(ke<S?ke:S)/KVBLK; }
  const bf16*Qw=Qs+(long)(q0+wid*QBLK)*PITCH;
  const bf16*Kh=Ks+(long)kt0*KVBLK*PITCH,*Vh=Vs+(long)kt0*KVBLK*PITCH;
  const unsigned lds0=(unsigned)(uintptr_t)shm;
  float*wsf=(float*)(shm+LDS_WS)+wid*64;
  const bf16*ksrc=Kh+(long)lane*PITCH+wid*8;
  const bf16*vsrc=Vh+(long)(16*(wid&3)+(lane>>2))*PITCH+(wid>>2)*32+(lane&3)*8;
  const unsigned kdst=lds0+LDS_K+wid*1024, vdst=lds0+LDS_V+wid*1024;
  #define DMA_K(t,slot) glds16(ksrc+(long)(t)*KVBLK*PITCH,(unsigned)__builtin_amdgcn_readfirstlane(kdst+(slot)))
  #define DMA_V(t,slot) glds16(vsrc+(long)(t)*KVBLK*PITCH,(unsigned)__builtin_amdgcn_readfirstlane(vdst+(slot)))
  const int vb0=(int)(lds0+LDS_V)+((lane>>4)&1)*32+(lane&3)*8+(4*hi+((lane&15)>>2))*64;
  const char*Kbase=shm+LDS_K; bf16x8 kf[8];
  const lds_cptr shm3=(lds_cptr)shm; const lds_cptr kp0=shm3+LDS_K+hi*1024+r32*16; const lds_cptr vp0=shm3+LDS_V+((lane>>4)&1)*32+(lane&3)*8+(4*hi+((lane&15)>>2))*64;
  const int NT=kend-kt0;
  DMA_K(0,0);DMA_V(0,0);DMA_K(1,SLOTB);
  bf16x8 qr[4];
  #pragma unroll
  for(int d0=0;d0<4;++d0)qr[d0]=*reinterpret_cast<const bf16x8*>(&Qw[(long)r32*PITCH+d0*16+hi*8]);
  float mhat=0.f,l_reg=0.f;f32x16 o[2];o[0]=f32x16{};o[1]=f32x16{};f32x16 negm=f32x16{};
  if(MODE==1){ mhat=sink2; l_reg=(hi==0)?1.f:0.f;
    #pragma unroll
    for(int r=0;r<16;++r)negm[r]=-sink2; }
  if(!NOMAX)asm volatile("":"+v"(negm));
  f32x16 lsum=f32x16{}; bf16x8 onesv;
  #pragma unroll
  for(int i_=0;i_<8;++i_)onesv[i_]=(short)0x3F80;
  asm volatile("":"+v"(onesv));
  const int qrel=wid*QBLK+r32;
  const int qk0=q0+qrel-kt0*KVBLK-4*hi;
  #define CMASK(P0,P1,t) do{ if(MODE==1) wmask(P0,P1,(float)(qk0-(t)*KVBLK),slope2); }while(0)
  bool resc=false;
  #define START(P0,P1) do{ resc=false; if(!NOMAX){ const float rm=rowmax(P0,P1); \
    if(MODE==0 || __any(rm>(float)THRL)) { const float dl=(MODE==0)?rm:__builtin_fmaxf(rm,0.f); mhat=fadd_s(mhat,dl); if(MODE==1) l_reg*=__builtin_amdgcn_exp2f(-dl); \
      _Pragma("unroll") for(int r=0;r<16;++r){P0[r]=fsub_s(P0[r],dl);P1[r]=fsub_s(P1[r],dl);} \
      _Pragma("unroll") for(int r=0;r<16;++r)negm[r]=-mhat; asm volatile("":"+v"(negm)); } } \
    _Pragma("unroll") for(int r=0;r<16;++r)P0[r]=__builtin_amdgcn_exp2f(P0[r]); }while(0)
  #define RESC() do{ if(resc){ asm volatile("s_waitcnt lgkmcnt(0)":::"memory"); \
      _Pragma("unroll") for(int d_=0;d_<2;++d_) _Pragma("unroll") for(int r=0;r<16;++r)o[d_][r]*=wsf[crow(r,hi)]; } }while(0)
  f32x16 pA0,pA1,pB0,pB1;
  int sl_prev=0,sl_cur=0,sl_next=SLOTB,sl_n2=2*SLOTB;
  #define ROT() do{sl_prev=sl_cur;sl_cur=sl_next;sl_next=sl_n2;sl_n2=(sl_n2==(NSLOT-1)*SLOTB)?0:sl_n2+SLOTB;}while(0)
  DMA_K(2,2*SLOTB);DMA_K(3,3*SLOTB);DMA_V(1,SLOTB);
  WAIT_BAR(5);
  qkt(pA0,pA1,Kbase,qr,(NOMAX?f32x16{}:negm),r32,hi);asm volatile("s_nop 15\n\ts_nop 7":"+v"(pA0),"+v"(pA1));CMASK(pA0,pA1,0);
  START(pA0,pA1);
  _Pragma("unroll") for(int r=0;r<16;++r)pA1[r]=__builtin_amdgcn_exp2f(pA1[r]);
  WAIT_BAR(2);
  DMA_K(4,4*SLOTB);DMA_V(2,2*SLOTB);
  ROT();
  kload8(kf,kp0+sl_cur);
  s16x4 vlo[8],vhi[8]; u32x4 pw0,pw1,pw2,pw3;
  #define PKW(P,B) cvtpk_s(P[B],P[B+1])
  #define PAF(k) __builtin_bit_cast(bf16x8,pw##k)
  #define VFR(i) (bf16x8){vlo[i][0],vlo[i][1],vlo[i][2],vlo[i][3],vhi[i][0],vhi[i][1],vhi[i][2],vhi[i][3]}
  #define PIN(x) asm volatile("":"+v"(x))
  #define MX3(a,b,c) __builtin_fmaxf(__builtin_fmaxf((a),(b)),(c))
  #define GAPA(MF,A0,A1,A2,A3,W0,W1,PW) do{ MF; if(!NOMAX){ sacc+=A0; sacc+=A1; sacc+=A2; sacc+=A3; PIN(sacc); } W0; W1; PIN(PW); SBAR(); }while(0)
  #define LSUM(k) do{ if(NOMAX){ lsum=__builtin_amdgcn_mfma_f32_32x32x16_bf16(PAF(k),onesv,lsum,0,0,0); SBAR(); } }while(0)
  #define NEGM (NOMAX?f32x16{}:negm)
  #define EX(v) __builtin_amdgcn_exp2f(v)
  #define GAPB(MF,X,B) do{ MF; X[B]=EX(X[B]); X[B+1]=EX(X[B+1]); X[B+2]=EX(X[B+2]); X[B+3]=EX(X[B+3]); PIN(X); SBAR(); }while(0)
  #define VRD(i) do{ vlo[i]=vtr(vp_+(((i)>>2)*4096+((i)&3)*1024)); vhi[i]=vtr(vp_+(((i)>>2)*4096+((i)&3)*1024+512)); }while(0)
  #define KRD(G,j) do{ if(G){ kload2(kf,kp0+sl_next,j); SBAR(); } }while(0)
  #define STEP(C0,C1,P0,P1,t,GK,GV,GL) do{ SBAR(); \
    const lds_cptr vp_=vp0+sl_prev; \
    VRD(0); SBAR(); float sacc=(P0[0]+P0[1]); \
    GAPA(C0=__builtin_amdgcn_mfma_f32_32x32x16_bf16(kf[0],qr[0],NEGM,0,0,0), P0[2],P0[3],P0[4],P0[5],     pw0[0]=PKW(P0,0), pw0[1]=PKW(P0,2), pw0); \
    VRD(4); SBAR(); GAPA(C1=__builtin_amdgcn_mfma_f32_32x32x16_bf16(kf[1],qr[0],NEGM,0,0,0), P0[6],P0[7],P0[8],P0[9],     pw0[2]=PKW(P0,4), pw0[3]=PKW(P0,6), pw0); \
    VRD(1); SBAR(); GAPA(C0=__builtin_amdgcn_mfma_f32_32x32x16_bf16(kf[2],qr[1],C0,0,0,0),   P0[10],P0[11],P0[12],P0[13], pw1[0]=PKW(P0,8), pw1[1]=PKW(P0,10), pw1); \
    VRD(5); SBAR(); GAPA(C1=__builtin_amdgcn_mfma_f32_32x32x16_bf16(kf[3],qr[1],C1,0,0,0),   P0[14],P0[15],P1[0],P1[1],   pw1[2]=PKW(P0,12),pw1[3]=PKW(P0,14), pw1); \
    VRD(2); SBAR(); GAPA(C0=__builtin_amdgcn_mfma_f32_32x32x16_bf16(kf[4],qr[2],C0,0,0,0),   P1[2],P1[3],P1[4],P1[5],     pw2[0]=PKW(P1,0), pw2[1]=PKW(P1,2), pw2); \
    VRD(6); SBAR(); GAPA(C1=__builtin_amdgcn_mfma_f32_32x32x16_bf16(kf[5],qr[2],C1,0,0,0),   P1[6],P1[7],P1[8],P1[9],     pw2[2]=PKW(P1,4), pw2[3]=PKW(P1,6), pw2); \
    VRD(3); SBAR(); GAPA(C0=__builtin_amdgcn_mfma_f32_32x32x16_bf16(kf[6],qr[3],C0,0,0,0),   P1[10],P1[11],P1[12],P1[13], pw3[0]=PKW(P1,8), pw3[1]=PKW(P1,10), pw3); \
    VRD(7); SBAR(); GAPA(C1=__builtin_amdgcn_mfma_f32_32x32x16_bf16(kf[7],qr[3],C1,0,0,0),   P1[14],P1[15],0.f,0.f,       pw3[2]=PKW(P1,12),pw3[3]=PKW(P1,14), pw3); \
    if(!NOMAX)l_reg+=sacc; \
    if(GK){DMA_K((t)+4,sl_prev);} if(GV){DMA_V((t)+2,sl_n2);} \
    CMASK(C0,C1,t); \
    if(!NOMAX){ float a=MX3(C0[0],C0[1],C1[0]),b=MX3(C0[2],C0[3],C1[1]); a=MX3(a,C1[2],C1[3]); \
      _Pragma("unroll") for(int r=4;r<16;r+=4){a=MX3(a,C0[r],C0[r+1]);b=MX3(b,C0[r+2],C0[r+3]);a=MX3(a,C1[r],C1[r+1]);b=MX3(b,C1[r+2],C1[r+3]);} \
      float rm=__builtin_fmaxf(a,b); { auto rr=__builtin_amdgcn_permlane32_swap(__float_as_uint(rm),__float_as_uint(rm),false,false); rm=__builtin_fmaxf(__uint_as_float(rr[0]),__uint_as_float(rr[1])); } \
      resc=false; \
      if(__builtin_expect(__any(rm>(float)THRL),0)){ const float dl=__builtin_fmaxf(rm,0.f); mhat+=dl; \
        _Pragma("unroll") for(int r=0;r<16;++r){C0[r]-=dl;C1[r]-=dl;} \
        _Pragma("unroll") for(int r=0;r<16;++r)negm[r]=-mhat; asm volatile("":"+v"(negm)); \
        const float f=__builtin_amdgcn_exp2f(-dl); l_reg*=f; if(hi==0)wsf[r32]=f; resc=true; } } \
    SBAR(); \
    GAPB(o[0]=__builtin_amdgcn_mfma_f32_32x32x16_bf16(PAF(0),VFR(0),o[0],0,0,0), C0,0); \
    GAPB(o[1]=__builtin_amdgcn_mfma_f32_32x32x16_bf16(PAF(0),VFR(4),o[1],0,0,0), C0,4); LSUM(0); \
    KRD(GL,0); GAPB(o[0]=__builtin_amdgcn_mfma_f32_32x32x16_bf16(PAF(1),VFR(1),o[0],0,0,0), C0,8); \
    KRD(GL,1); GAPB(o[1]=__builtin_amdgcn_mfma_f32_32x32x16_bf16(PAF(1),VFR(5),o[1],0,0,0), C0,12); LSUM(1); \
    KRD(GL,2); GAPB(o[0]=__builtin_amdgcn_mfma_f32_32x32x16_bf16(PAF(2),VFR(2),o[0],0,0,0), C1,0); \
    KRD(GL,3); GAPB(o[1]=__builtin_amdgcn_mfma_f32_32x32x16_bf16(PAF(2),VFR(6),o[1],0,0,0), C1,4); LSUM(2); \
    GAPB(o[0]=__builtin_amdgcn_mfma_f32_32x32x16_bf16(PAF(3),VFR(3),o[0],0,0,0), C1,8); \
    GAPB(o[1]=__builtin_amdgcn_mfma_f32_32x32x16_bf16(PAF(3),VFR(7),o[1],0,0,0), C1,12); LSUM(3); \
    }while(0)
  int t=1;
  for(;t+5<NT;t+=2){
    STEP(pB0,pB1,pA0,pA1,t,true,true,true);     WAIT_BAR(2); RESC(); ROT();
    STEP(pA0,pA1,pB0,pB1,t+1,true,true,true);   RESC(); ROT();
  }
  #define ENDW(tt) do{ if((tt)+4<NT){WAIT_BAR(2);} else if((tt)+2<NT){WAIT_BAR(1);} else {WAIT_BAR(0);} }while(0)
  for(;t+1<NT;t+=2){
    STEP(pB0,pB1,pA0,pA1,t,(t+4<NT),(t+2<NT),(t+1<NT));       ENDW(t);   RESC(); ROT();
    STEP(pA0,pA1,pB0,pB1,t+1,(t+5<NT),(t+3<NT),(t+2<NT));     if(t+3>=NT){WAIT_BAR(0);} RESC(); ROT();
  }
  STEP(pB0,pB1,pA0,pA1,NT-1,false,false,false); RESC();
  { float sacc=pB0[0]+pB0[1]; _Pragma("unroll") for(int r=2;r<16;++r)sacc+=pB0[r]; _Pragma("unroll") for(int r=0;r<16;++r)sacc+=pB1[r]; l_reg+=sacc;
    pw0=(u32x4){PKW(pB0,0),PKW(pB0,2),PKW(pB0,4),PKW(pB0,6)};pw1=(u32x4){PKW(pB0,8),PKW(pB0,10),PKW(pB0,12),PKW(pB0,14)};pw2=(u32x4){PKW(pB1,0),PKW(pB1,2),PKW(pB1,4),PKW(pB1,6)};pw3=(u32x4){PKW(pB1,8),PKW(pB1,10),PKW(pB1,12),PKW(pB1,14)};
    SBAR(); pv(o,vb0+sl_cur,PAF(0),PAF(1),PAF(2),PAF(3)); LSUM(0); LSUM(1); LSUM(2); LSUM(3); }
  #undef PKW
  #undef PAF
  #undef VFR
  #undef PIN
  #undef MX3
  #undef GAPA
  #undef LSUM
  #undef GAPB
  #undef EX
  #undef VRD
  #undef KRD
  #undef STEP
  #undef ENDW
  {auto rr=__builtin_amdgcn_permlane32_swap(__float_as_uint(l_reg),__float_as_uint(l_reg),false,false);l_reg=__uint_as_float(rr[0])+__uint_as_float(rr[1]);}
  if(hi==0)wsf[32+r32]=l_reg;asm volatile("s_waitcnt lgkmcnt(0)":::"memory");
  float rli[16];
  #pragma unroll
  for(int r=0;r<16;++r)rli[r]=NOMAX?__builtin_amdgcn_rcpf(lsum[r]):__builtin_amdgcn_rcpf(wsf[32+crow(r,hi)]);
  #undef NEGM
  bf16*Ow=Os+(long)(q0+wid*QBLK)*OPITCH;
  { bf16*stg=(bf16*)(shm+LDS_OST)+wid*2048;
    #pragma unroll
    for(int r=0;r<16;++r){const int orow=crow(r,hi);
      #pragma unroll
      for(int d0=0;d0<2;++d0)stg[orow*64+d0*32+r32]=__float2bfloat16(o[d0][r]*rli[r]);}
    asm volatile("s_waitcnt lgkmcnt(0)":::"memory");
    #pragma unroll
    for(int i=0;i<4;++i){const int row=i*8+(lane>>3),ch=lane&7; const u32x4 v=*(const u32x4*)(stg+row*64+ch*8); ATTN_STORE16(Ow+(long)row*OPITCH+ch*8,v);
      float sq=0.f;
      #pragma unroll
      for(int k=0;k<4;++k){const float a=__uint_as_float(v[k]<<16),b=__uint_as_float(v[k]&0xffff0000u); sq+=a*a+b*b;}
      sq+=__shfl_xor(sq,1); sq+=__shfl_xor(sq,2); sq+=__shfl_xor(sq,4);
      if(ch==0)ssq[(long)(q0+wid*QBLK+row)*16]=sq;} }
  asm volatile("s_waitcnt lgkmcnt(0)\n\ts_barrier":::"memory");
  #undef DMA_K
  #undef DMA_V
  #undef CMASK
  #undef START
  #undef RESC
  #undef ROT
}
constexpr int ATTN_LDS_BYTES=LDS_BYTES;
#undef SBAR
#undef WAIT_BAR
}
#include <hip/hip_cooperative_groups.h>
namespace cg = cooperative_groups;
constexpr int NWAVES = 8;
#ifndef PHASES
#define PHASES 0xffff
#endif
#define PH(n) if constexpr ((PHASES >> (n)) & 1)
#ifndef REP_SYNC
#define REP_SYNC 1
#endif
#ifndef REP_PRO
#define REP_PRO 1
#endif
#ifndef REP_EPOST
#define REP_EPOST 1
#endif
#ifndef REP_ONORM
#define REP_ONORM 1
#endif
#if REP_SYNC == 2
#define GSYNC() do { xcd_barrier(xbar, MYTID() == 0); xcd_barrier(xbar, MYTID() == 0); } while (0)
#else
#define GSYNC() xcd_barrier(xbar, MYTID() == 0)
#endif
#ifndef GEMM_SP2
#define GEMM_SP2 true
#endif
#ifndef HALF_TAIL_GU
#define HALF_TAIL_GU false
#endif
#ifndef SWIGLU_ALIGN
#define SWIGLU_ALIGN true
#endif
#ifndef REP_GU
#define REP_GU REP_GEMM
#endif
#ifndef REP_DN
#define REP_DN REP_GEMM
#endif
#ifndef REP_ATTN
#define REP_ATTN 1
#endif
#ifndef REP_GEMM
#define REP_GEMM 1
#endif
constexpr int DM = 1024, DFF = 2816, NIN = 1536, DEPTH = 2;
constexpr int M_P = 32768, M_S = 16384, M = M_P + M_S;
constexpr int S_P = 16384, S_S = 8192;
constexpr float EPS = 1e-6f;
constexpr float LOG2E = 1.4426950408889634f;
constexpr size_t MiB = 1u << 20;
constexpr int RING_BYTES = 131072, LDS_BYTES = 147456;
constexpr size_t W_LAYER = 38 * MiB, W_GU1 = 0, W_D1 = 11 * MiB, W_IN = 16 * MiB + MiB / 2, W_OUT = 19 * MiB + MiB / 2, W_GU2 = 21 * MiB + MiB / 2, W_D2 = 32 * MiB + MiB / 2;
constexpr size_t WS_ACT = 76 * MiB, WS_BIG = 172 * MiB, WS_O = WS_BIG + 144 * MiB, WS_RSX = 436 * MiB, WS_SSQ = 437 * MiB, WS_END = 441 * MiB;
constexpr int YLD = 2048;
constexpr size_t WS_CTL = WS_RSX + 512 * 1024, CTL_BYTES = 16384;
constexpr int MISC_OFF = RING_BYTES + 320;
static_assert(W_D2 + (size_t)DM * DFF * 2 == W_LAYER && WS_ACT + (size_t)M * DM * 2 == WS_BIG && WS_BIG + (size_t)M * DFF * 2 == WS_RSX && WS_O + (size_t)M * DM * 2 <= WS_END, "ws map");
#define LAS __attribute__((address_space(3)))
typedef unsigned short bfu;
typedef unsigned v4u __attribute__((ext_vector_type(4)));
typedef unsigned v2u __attribute__((ext_vector_type(2)));
typedef float f32x4 __attribute__((ext_vector_type(4)));
#define LDS_WAIT() asm volatile("s_waitcnt lgkmcnt(0)" ::: "memory")
__device__ __forceinline__ unsigned pk2(float lo, float hi) { return pg8::cvt_pk_bf16(lo, hi); }
__device__ __forceinline__ float bflo(unsigned w) { return __uint_as_float(w << 16); }
__device__ __forceinline__ float bfhi(unsigned w) { return __uint_as_float(w & 0xffff0000u); }
__device__ __forceinline__ float wave_sum(float v) {
#pragma unroll
    for (int o = 1; o < 64; o <<= 1) v += __shfl_xor(v, o);
    return v;
}
__device__ __forceinline__ int lsg(int x) { asm volatile("" : "+s"(x)); return x; }
__device__ __forceinline__ float dot4(f32x4 a) { return (a.x * a.x + a.y * a.y) + (a.z * a.z + a.w * a.w); }

__device__ __forceinline__ void transpose_item(const float* W, int K, int N, bfu* WT, const float* g, const float* g2, int mode, LAS float* scr, int item, int lane) {
    const int nblk = N / 32, kb = item / nblk, nb = item % nblk, k0 = 64 * kb, n0 = 32 * nb;
    const float* gp = g ? ((g2 && k0 >= 512) ? g2 + (k0 - 512) : g + k0) : nullptr;
#pragma unroll
    for (int i = 0; i < 32; ++i) { const int kk = 2 * i + (lane >> 5); const float gv = gp ? gp[kk] : 1.0f; scr[kk * 33 + (lane & 31)] = W[(size_t)(k0 + kk) * N + n0 + (lane & 31)] * gv; }
    LDS_WAIT(); asm volatile("" ::: "memory");
    const int c = lane & 7;
    const int r0 = (mode == 0) ? n0 : (mode == 3) ? ((n0 & ~255) + 128 * ((n0 >> 5) & 1) + 32 * ((n0 >> 6) & 3)) : (256 * (n0 >> 7) + (n0 & 127) + (mode == 2 ? 128 : 0));
#pragma unroll
    for (int j = 0; j < 4; ++j) { const int n = (lane >> 3) + 8 * j; const LAS float* s = scr + (8 * c) * 33 + n;
        v4u o; o.x = pk2(s[0 * 33], s[1 * 33]); o.y = pk2(s[2 * 33], s[3 * 33]); o.z = pk2(s[4 * 33], s[5 * 33]); o.w = pk2(s[6 * 33], s[7 * 33]);
        *(v4u*)(WT + (size_t)(r0 + n) * K + k0 + 8 * c) = o; }
    LDS_WAIT(); asm volatile("" ::: "memory");
}
struct TiDesc { const float* W; bfu* WT; const float* g; const float* g2; int K, N, mode, item; };
__device__ __forceinline__ void ti_load(const TiDesc& d, int lane, f32x4 (&v)[8], f32x4 (&gv)[2], size_t& dst) {
    const int nblk = d.N / 32, kb = d.item / nblk, nb = d.item % nblk, k0 = 64 * kb, n0 = 32 * nb, ng = lane & 7, kg = lane >> 3;
    const float* src = d.W + (size_t)(k0 + 8 * kg) * d.N + n0 + 4 * ng;
#pragma unroll
    for (int i = 0; i < 8; ++i) v[i] = *(const f32x4*)(src + (size_t)i * d.N);
    if (d.g) { const float* gp = ((d.g2 && k0 >= 512) ? d.g2 + (k0 - 512) : d.g + k0) + 8 * kg; gv[0] = *(const f32x4*)gp; gv[1] = *(const f32x4*)(gp + 4); }
    else { gv[0] = (f32x4){1.f, 1.f, 1.f, 1.f}; gv[1] = gv[0]; }
    const int r0 = (d.mode == 0) ? n0 : (d.mode == 3) ? ((n0 & ~255) + 128 * ((n0 >> 5) & 1) + 32 * ((n0 >> 6) & 3)) : (256 * (n0 >> 7) + (n0 & 127) + (d.mode == 2 ? 128 : 0));
    dst = (size_t)(r0 + 4 * ng) * d.K + k0 + 8 * kg;
}
__device__ __forceinline__ void ti_store(const TiDesc& d, const f32x4 (&v)[8], const f32x4 (&gv)[2], size_t dst) {
#pragma unroll
    for (int j = 0; j < 4; ++j) { v4u o; o.x = pk2(v[0][j] * gv[0][0], v[1][j] * gv[0][1]); o.y = pk2(v[2][j] * gv[0][2], v[3][j] * gv[0][3]); o.z = pk2(v[4][j] * gv[1][0], v[5][j] * gv[1][1]); o.w = pk2(v[6][j] * gv[1][2], v[7][j] * gv[1][3]);
        *(v4u*)(d.WT + dst + (size_t)j * d.K) = o; }
}
__device__ __forceinline__ void unpack8(const v4u w, float (&x)[8]) { x[0] = bflo(w.x); x[1] = bfhi(w.x); x[2] = bflo(w.y); x[3] = bfhi(w.y); x[4] = bflo(w.z); x[5] = bfhi(w.z); x[6] = bflo(w.w); x[7] = bfhi(w.w); }
__device__ __forceinline__ v4u pack8(const float (&x)[8]) { v4u r; r.x = pk2(x[0], x[1]); r.y = pk2(x[2], x[3]); r.z = pk2(x[4], x[5]); r.w = pk2(x[6], x[7]); return r; }
template <int R> __device__ __forceinline__ void wave_sum_n(float (&v)[R]) {
#pragma unroll
    for (int o = 1; o < 64; o <<= 1) {
#pragma unroll
        for (int r = 0; r < R; ++r) v[r] += __shfl_xor(v[r], o); }
}
__device__ __forceinline__ void e_first_rows4(const float* x0, bfu* xb0, float* rsx, int lane) {
    f32x4 v[4][2][2];
#pragma unroll
    for (int r = 0; r < 4; ++r)
#pragma unroll
        for (int h = 0; h < 2; ++h) { const f32x4* p = (const f32x4*)(x0 + (size_t)r * DM + 512 * h + 8 * lane); v[r][h][0] = p[0]; v[r][h][1] = p[1]; }
    float ss[4];
#pragma unroll
    for (int r = 0; r < 4; ++r) { ss[r] = (dot4(v[r][0][0]) + dot4(v[r][0][1])) + (dot4(v[r][1][0]) + dot4(v[r][1][1]));
#pragma unroll
        for (int h = 0; h < 2; ++h) { v4u w; w.x = pk2(v[r][h][0].x, v[r][h][0].y); w.y = pk2(v[r][h][0].z, v[r][h][0].w); w.z = pk2(v[r][h][1].x, v[r][h][1].y); w.w = pk2(v[r][h][1].z, v[r][h][1].w);
            *(v4u*)(xb0 + (size_t)r * DM + 512 * h + 8 * lane) = w; } }
    wave_sum_n<4>(ss);
    if (lane < 4) { const float sv = lane == 0 ? ss[0] : lane == 1 ? ss[1] : lane == 2 ? ss[2] : ss[3]; rsx[lane] = __builtin_amdgcn_rsqf(sv * (1.f / DM) + EPS); }
}
template <bool FINAL, int R> __device__ __forceinline__ void e_post_rows(const bfu* y0, bfu* xb0, float* rsx, float* out0, const float* gpost, float scale, int lane) {
    v4u yw[R][2], xw[R][2];
#pragma unroll
    for (int r = 0; r < R; ++r)
#pragma unroll
        for (int h = 0; h < 2; ++h) { yw[r][h] = *(const v4u*)(y0 + (size_t)r * YLD + 512 * h + 8 * lane); xw[r][h] = *(const v4u*)(xb0 + (size_t)r * DM + 512 * h + 8 * lane); }
    asm volatile("" ::: "memory");
    f32x4 g[2][2];
#pragma unroll
    for (int h = 0; h < 2; ++h) { const f32x4* p = (const f32x4*)(gpost + 512 * h + 8 * lane); g[h][0] = p[0]; g[h][1] = p[1]; }
    float sy[R];
#pragma unroll
    for (int r = 0; r < R; ++r) { float a = 0.f;
#pragma unroll
        for (int h = 0; h < 2; ++h) { float y[8]; unpack8(yw[r][h], y);
#pragma unroll
            for (int k = 0; k < 8; ++k) a += y[k] * y[k]; }
        sy[r] = a; }
    wave_sum_n<R>(sy);
    float sx[R];
#pragma unroll
    for (int r = 0; r < R; ++r) { const float rs = __builtin_amdgcn_rsqf(sy[r] * (1.f / DM) + EPS) * scale; float a = 0.f;
#pragma unroll
        for (int h = 0; h < 2; ++h) { float y[8], x[8]; unpack8(yw[r][h], y); unpack8(xw[r][h], x);
            const float gg[8] = {g[h][0].x, g[h][0].y, g[h][0].z, g[h][0].w, g[h][1].x, g[h][1].y, g[h][1].z, g[h][1].w};
#pragma unroll
            for (int k = 0; k < 8; ++k) { x[k] = x[k] + y[k] * rs * gg[k]; a += x[k] * x[k]; }
            if (FINAL) { f32x4* po = (f32x4*)(out0 + (size_t)r * DM + 512 * h + 8 * lane); po[0] = (f32x4){x[0], x[1], x[2], x[3]}; po[1] = (f32x4){x[4], x[5], x[6], x[7]}; }
            else *(v4u*)(xb0 + (size_t)r * DM + 512 * h + 8 * lane) = pack8(x); }
        sx[r] = a; }
    if (!FINAL) { wave_sum_n<R>(sx);
        float sv = sx[0];
#pragma unroll
        for (int r = 1; r < R; ++r) sv = (lane == r) ? sx[r] : sv;
        if (lane < R) rsx[lane] = __builtin_amdgcn_rsqf(sv * (1.f / DM) + EPS); }
}
__device__ __forceinline__ void e_onorm_rows4(bfu* o0, int lane) {
    v4u w[4][2];
#pragma unroll
    for (int r = 0; r < 4; ++r)
#pragma unroll
        for (int h = 0; h < 2; ++h) w[r][h] = *(const v4u*)(o0 + (size_t)r * DM + 512 * h + 8 * lane);
    float ss[8];
#pragma unroll
    for (int r = 0; r < 4; ++r)
#pragma unroll
        for (int h = 0; h < 2; ++h) { float x[8]; unpack8(w[r][h], x); float a = 0.f;
#pragma unroll
            for (int k = 0; k < 8; ++k) a += x[k] * x[k];
            ss[2 * r + h] = a; }
    wave_sum_n<8>(ss);
#pragma unroll
    for (int r = 0; r < 4; ++r)
#pragma unroll
        for (int h = 0; h < 2; ++h) { float x[8]; unpack8(w[r][h], x); const float rstd = __builtin_amdgcn_rsqf(ss[2 * r + h] * (1.f / 512.f) + EPS);
#pragma unroll
            for (int k = 0; k < 8; ++k) x[k] *= rstd;
            *(v4u*)(o0 + (size_t)r * DM + 512 * h + 8 * lane) = pack8(x); }
}
#define XB_TMO      128
#define XB_XCNT(j)  (256  + 64 * (j))
#define XB_XSUB(j)  (1280 + 64 * (j))
#define XB_XGEN(j)  (2304 + 64 * (j))
#define XB_TOP      3328
#define XB_TOPGEN   3392
#define XCD_BAR_WORDS 3456
#define XB_SPIN_CAP (1u << 18)

__device__ __forceinline__ unsigned xb_ld(unsigned* p)              { return __hip_atomic_load(p, __ATOMIC_RELAXED, __HIP_MEMORY_SCOPE_AGENT); }
__device__ __forceinline__ unsigned xb_add(unsigned* p, unsigned v) { return __hip_atomic_fetch_add(p, v, __ATOMIC_RELAXED, __HIP_MEMORY_SCOPE_AGENT); }
__device__ __forceinline__ unsigned xb_xcc_id() { return (unsigned)__builtin_amdgcn_s_getreg((3 << 11) | 20) & 0xFu; }
#define XB_SPIN(cond, bar) do { unsigned _sp = 0; while (cond) { __builtin_amdgcn_s_sleep(1); \
    if ((++_sp & 255u) == 0u) { if (xb_ld(&(bar)[XB_TMO])) break; if (_sp > XB_SPIN_CAP) { atomicAdd(&(bar)[XB_TMO], 1u); break; } } } } while (0)

struct XcdBarrier {
    unsigned* bar; unsigned x;
    volatile LAS unsigned* st;
};

__device__ __forceinline__ XcdBarrier xcd_barrier_post(unsigned* bar, volatile LAS unsigned* st, bool t0) {
    XcdBarrier b; b.bar = bar; b.x = xb_xcc_id(); b.st = st;
    if (t0) (void)xb_add(&bar[XB_XCNT(b.x)], 1u);
    return b;
}
__device__ __forceinline__ void xcd_barrier_complete(unsigned* bar, unsigned x, unsigned& nloc, unsigned& nx) {
    const unsigned G = gridDim.x * gridDim.y * gridDim.z;
    unsigned sum, cnt, mine, sp = 0u;
    for (;;) {
        sum = 0u; cnt = 0u; mine = 0u;
#pragma unroll
        for (unsigned j = 0; j < 16; ++j) { const unsigned c = xb_ld(&bar[XB_XCNT(j)]); sum += c; cnt += (c > 0u) ? 1u : 0u; mine = (j == x) ? c : mine; }
        if (sum == G) break;
        __builtin_amdgcn_s_sleep(1);
        if ((++sp & 255u) == 0u) { if (xb_ld(&bar[XB_TMO])) break; if (sp > XB_SPIN_CAP) { atomicAdd(&bar[XB_TMO], 1u); break; } }
    }
    nloc = mine > 0u ? mine : 1u; nx = cnt > 0u ? cnt : 1u;
}

__device__ __forceinline__ void xcd_barrier(const XcdBarrier& b, bool t0) {
    asm volatile("s_waitcnt vmcnt(0)" ::: "memory");
    __syncthreads();
    if (t0) {
        unsigned* bar = b.bar;
        __builtin_amdgcn_s_waitcnt(0);
        unsigned nloc = b.st[0], nx = b.st[1];
        if (nloc == 0u) { xcd_barrier_complete(bar, b.x, nloc, nx); b.st[0] = nloc; b.st[1] = nx; }
        const unsigned old = xb_add(&bar[XB_XSUB(b.x)], 1u);
        const unsigned gen = old / nloc;
        if (old + 1u == (gen + 1u) * nloc) {
            __builtin_amdgcn_fence(__ATOMIC_RELEASE, "agent");
            asm volatile("s_waitcnt vmcnt(0)" ::: "memory");
            const unsigned og = xb_add(&bar[XB_TOP], 1u);
            const unsigned tg = og / nx;
            if (og + 1u == (tg + 1u) * nx) xb_add(&bar[XB_TOPGEN], 1u);
            else XB_SPIN(xb_ld(&bar[XB_TOPGEN]) == tg, bar);
            __builtin_amdgcn_fence(__ATOMIC_ACQUIRE, "agent");
            xb_add(&bar[XB_XGEN(b.x)], 1u);
            asm volatile("s_waitcnt vmcnt(0)" ::: "memory");
        } else {
            XB_SPIN(xb_ld(&bar[XB_XGEN(b.x)]) == gen, bar);
            __builtin_amdgcn_fence(__ATOMIC_ACQUIRE, "agent");
            asm volatile("s_waitcnt vmcnt(0)" ::: "memory");
        }
    }
    __syncthreads();
}

__device__ __forceinline__ void attn_phase(char* lds, const attn_body::bf16* P, attn_body::bf16* O, const float* sink, float* ssq, const float* gq, const float* gk, int vcu, int G, int tid_in) {
    bool nomax;
    { int ln_ = tid_in & 63; float a = __builtin_fabsf(gq[ln_]), b = __builtin_fabsf(gk[ln_]);
#pragma unroll
      for (int o = 1; o < 64; o <<= 1) { a = __builtin_fmaxf(a, __shfl_xor(a, o)); b = __builtin_fmaxf(b, __shfl_xor(b, o)); }
      const float B2 = 64.f * a * b * attn_body::C2; nomax = __builtin_amdgcn_readfirstlane((int)(B2 < 96.f)) != 0; }
    for (int L = vcu; L < 3072; L += G) {
        int mode, S, rowbase, q0, hq;
        if (L < 1536) {
            mode = 0; int b, hkv, g, qb;
            if (L < 1024) { const int i = L >> 8, v = L & 255, x = v >> 5, c = v & 31, u = 128 * (x & 1) + i * 32 + c, combo = x >> 1; b = combo >> 1; hkv = combo & 1; g = u >> 6; qb = u & 63; S = S_P; rowbase = b * S_P; }
            else { const int Ls = L - 1024, i = Ls >> 8, v = Ls & 255, x = v >> 5, c = v & 31, u = 64 * (x & 1) + i * 32 + c, combo = x >> 1; b = combo >> 1; hkv = combo & 1; g = u >> 5; qb = u & 31; S = S_S; rowbase = M_P + b * S_S; }
            hq = hkv * 4 + g; q0 = qb * 256;
        } else {
            mode = 1; const int Lw = L - 1536; hq = Lw & 7; const int row0 = (Lw >> 3) * 256;
            if (row0 < M_P) { S = S_P; rowbase = row0 & ~(S_P - 1); } else { S = S_S; rowbase = M_P + ((row0 - M_P) & ~(S_S - 1)); }
            q0 = row0 - rowbase;
        }
        const attn_body::bf16* Q = P + (size_t)rowbase * NIN + mode * 768 + hq * 64;
        const attn_body::bf16* K = P + (size_t)rowbase * NIN + mode * 768 + 512 + (hq >> 2) * 64;
        const attn_body::bf16* V = K + 128;
        attn_body::bf16* Oo = O + (size_t)rowbase * DM + mode * 512 + hq * 64; float* sq = ssq + (size_t)rowbase * 16 + mode * 8 + hq;
        if (mode == 0) { if (nomax) attn_body::attn_unit<0, 8, true>(Q, K, V, Oo, S, q0, 0.f, 0.f, sq, lds, tid_in); else attn_body::attn_unit<0, 8, false>(Q, K, V, Oo, S, q0, 0.f, 0.f, sq, lds, tid_in); }
        else { const float sink2 = sink[hq] * LOG2E; const float slope2 = __builtin_amdgcn_exp2f(-(float)(hq + 1)) * LOG2E; attn_body::attn_unit<1, 8, false>(Q, K, V, Oo, S, q0, sink2, slope2, sq, lds, tid_in); }
    }
}

struct Args { const float* in[21]; float* out; unsigned char* ws; };
__global__ void __launch_bounds__(NWAVES * 64, 2) mega_fwd(Args args) {
    extern __shared__ __attribute__((aligned(16))) unsigned char lds[];
    cg::grid_group grid = cg::this_grid();
    const int wave = __builtin_amdgcn_readfirstlane((int)threadIdx.x >> 6);
#define lane ({ int l_ = (int)__builtin_amdgcn_mbcnt_hi(~0u, __builtin_amdgcn_mbcnt_lo(~0u, 0u)); asm volatile("" : "+v"(l_)); l_; })
#define MYTID() ((wave << 6) | lane)
    const int G = gridDim.x; const int bx = blockIdx.x; const int vcu = (G % 8 == 0) ? (bx % 8) * (G / 8) + bx / 8 : bx;
    const int gw = vcu * NWAVES + wave, NGW = G * NWAVES;
    typedef const __attribute__((address_space(4))) Args* kargp_t;
    kargp_t kap = (kargp_t)__builtin_amdgcn_kernarg_segment_ptr();
#define KARG() ({ kargp_t p_ = kap; asm volatile("" : "+s"(p_)); p_; })
#define INP(i) (KARG()->in[i])
#define ws (KARG()->ws)
#define xout (KARG()->out)
#define XB ((bfu*)(ws + WS_ACT))
#define HB ((bfu*)(ws + WS_BIG))
#define PB ((bfu*)(ws + WS_BIG))
#define OB ((bfu*)(ws + WS_O))
#define RSX ((float*)(ws + WS_RSX))
#define SSQ ((float*)(ws + WS_SSQ))
#define YB ((bfu*)xout)
    LAS unsigned char* ldsp = (LAS unsigned char*)lds;
    if (MYTID() < 32) ((LAS unsigned*)(ldsp + MISC_OFF))[MYTID()] = 0u;
    __syncthreads();
    XcdBarrier xbar = xcd_barrier_post((unsigned*)(ws + WS_CTL), (volatile LAS unsigned*)(ldsp + MISC_OFF) + 8, MYTID() == 0);

    constexpr int I_G = (DM / 64) * (DFF / 32), I_D = (DFF / 64) * (DM / 32), I_I = (DM / 64) * (NIN / 32), I_O = (DM / 64) * (DM / 32);
    constexpr int PER_LAYER = 4 * I_G + 2 * I_D + I_I + I_O;
#define TI_DECODE(d, it_) do { const int l_ = (it_) / PER_LAYER; int r = (it_) % PER_LAYER; unsigned char* wl_ = ws + (size_t)l_ * W_LAYER; \
            if (r < I_G) { d = TiDesc{INP(4) + (size_t)l_ * DM * DFF, (bfu*)(wl_ + W_GU1), INP(2) + l_ * DM, nullptr, DM, DFF, 1, r}; break; } r -= I_G; \
            if (r < I_G) { d = TiDesc{INP(5) + (size_t)l_ * DM * DFF, (bfu*)(wl_ + W_GU1), INP(2) + l_ * DM, nullptr, DM, DFF, 2, r}; break; } r -= I_G; \
            if (r < I_D) { d = TiDesc{INP(6) + (size_t)l_ * DM * DFF, (bfu*)(wl_ + W_D1), nullptr, nullptr, DFF, DM, 0, r}; break; } r -= I_D; \
            if (r < I_I) { d = TiDesc{INP(9) + (size_t)l_ * DM * NIN, (bfu*)(wl_ + W_IN), INP(7) + l_ * DM, nullptr, DM, NIN, 3, r}; break; } r -= I_I; \
            if (r < I_O) { d = TiDesc{INP(15) + (size_t)l_ * DM * DM, (bfu*)(wl_ + W_OUT), INP(13) + l_ * 512, INP(14) + l_ * 512, DM, DM, 0, r}; break; } r -= I_O; \
            if (r < I_G) { d = TiDesc{INP(18) + (size_t)l_ * DM * DFF, (bfu*)(wl_ + W_GU2), INP(16) + l_ * DM, nullptr, DM, DFF, 1, r}; break; } r -= I_G; \
            if (r < I_G) { d = TiDesc{INP(19) + (size_t)l_ * DM * DFF, (bfu*)(wl_ + W_GU2), INP(16) + l_ * DM, nullptr, DM, DFF, 2, r}; break; } r -= I_G; \
            d = TiDesc{INP(20) + (size_t)l_ * DM * DFF, (bfu*)(wl_ + W_D2), nullptr, nullptr, DFF, DM, 0, r}; } while (0)
#define CONV_RANGE(LO, HI, W0, NW) do { const int ln_ = lane; const int nw_ = (NW); for (int it = (LO) + (W0); it < (HI); it += 2 * nw_) { \
            TiDesc da, db; f32x4 va[8], vb[8], ga[2], gb[2]; size_t dsta, dstb = 0; const bool two = (it + nw_) < (HI); \
            TI_DECODE(da, it); ti_load(da, ln_, va, ga, dsta); \
            if (two) { TI_DECODE(db, it + nw_); ti_load(db, ln_, vb, gb, dstb); } \
            ti_store(da, va, ga, dsta); \
            if (two) ti_store(db, vb, gb, dstb); } } while (0)
#ifndef TAIL_CONV
#define TAIL_CONV 0
#endif
#define CONV_TAIL(LO, HI, NWG) do { const int G_ = lsg(G), rem_ = (NWG) % G_, bx_ = lsg(bx); const int lo_ = lsg(LO), hi_ = lsg(HI); \
            int w0_ = lsg(gw), nw_t = lsg(NGW); if (rem_ != 0) { w0_ = (bx_ - rem_) * NWAVES + wave; nw_t = (G_ - rem_) * NWAVES; } \
            if (rem_ == 0 || bx_ >= rem_) { asm volatile("" ::: "memory"); CONV_RANGE(lo_, hi_, lsg(w0_), lsg(nw_t)); asm volatile("" ::: "memory"); } } while (0)
    PH(0) for (int rp = 0; rp < REP_PRO; ++rp) {
        CONV_RANGE(0, TAIL_CONV ? 2 * I_G : DEPTH * PER_LAYER, lsg(gw), lsg(NGW));
        for (int m = 4 * lsg(gw); m < M; m += 4 * lsg(NGW)) { const float* xr = (m < M_P) ? INP(0) + (size_t)m * DM : INP(1) + (size_t)(m - M_P) * DM; e_first_rows4(xr, XB + (size_t)m * DM, RSX + m, lane); }
    }
    grid.sync();

#define GEMM_SWIGLU(WOFF) do { pg8::Gemm g{XB, (const bfu*)(wl + (WOFF)), M, 2 * DFF, DM}; pg8::StaticOrder S; S.init(M, 2 * DFF, lsg(G), lsg(bx), HALF_TAIL_GU); pg8::EpiSwiGLU E{HB, DFF, RSX}; \
        pg8::gemm_phase<pg8::EpiSwiGLU, pg8::StaticOrder, SWIGLU_ALIGN, GEMM_SP2>(ldsp, g, S, E, MYTID()); } while (0)
#ifndef DOWN_REV
#define DOWN_REV true
#endif
#define GEMM_PLAIN(A_, WOFF, N_, K_, O_, LDC) do { pg8::Gemm g{(A_), (const bfu*)(wl + (WOFF)), M, (N_), (K_)}; pg8::StaticOrder S; S.init(M, (N_), lsg(G), lsg(bx), false, DOWN_REV); pg8::EpiPlain E{(O_), (LDC), 0, 0, 1.0f}; \
        pg8::gemm_phase<pg8::EpiPlain, pg8::StaticOrder, true, GEMM_SP2>(ldsp, g, S, E, MYTID()); } while (0)
#define GEMM_WIN() do { pg8::Gemm g{XB, (const bfu*)(wl + W_IN), M, NIN, DM}; pg8::StaticOrder S; S.init(M, NIN, lsg(G), lsg(bx)); pg8::EpiWin E{PB, RSX, INP(10) + l * 64, INP(11) + l * 64, attn_body::C2}; \
        pg8::gemm_phase<pg8::EpiWin, pg8::StaticOrder, true, GEMM_SP2>(ldsp, g, S, E, MYTID()); } while (0)
#define GEMM_WOUT() do { pg8::Gemm g{OB, (const bfu*)(wl + W_OUT), M, DM, DM}; pg8::StaticOrder S; S.init(M, DM, lsg(G), lsg(bx)); pg8::EpiOutNorm E{YB, YLD, SSQ}; \
        pg8::gemm_phase<pg8::EpiOutNorm, pg8::StaticOrder, true, GEMM_SP2>(ldsp, g, S, E, MYTID()); } while (0)
#ifndef EP_ROWS
#define EP_ROWS 4
#endif
#define E_POST(GP, SCALE, FINAL) do { for (int rp = 0; rp < ((FINAL) ? 1 : REP_EPOST); ++rp) for (int m = EP_ROWS * lsg(gw); m < M; m += EP_ROWS * lsg(NGW)) \
        e_post_rows<FINAL, EP_ROWS>(YB + (size_t)m * YLD, XB + (size_t)m * DM, RSX + m, xout + (size_t)m * DM, (GP), rp == 0 ? (SCALE) : 0.0f, lane); } while (0)

#pragma nounroll
    for (int l = 0; l < DEPTH; ++l) {
#define wl (ws + (size_t)l * W_LAYER)
        PH(1) for (int rp = 0; rp < REP_GU; ++rp) GEMM_SWIGLU(W_GU1);
        if (TAIL_CONV && l == 0) CONV_TAIL(2 * I_G, PER_LAYER, (M / 256) * (2 * DFF / 256));
        GSYNC();
        PH(2) { GEMM_PLAIN(HB, W_D1, DM, DFF, YB, YLD); if (REP_DN == 2) GEMM_PLAIN(HB, W_D1, DM, DFF, YB, YLD); }
        GSYNC();
        PH(3) E_POST(INP(3) + l * DM, 0.5f, false);
        GSYNC();
        PH(4) for (int rp = 0; rp < REP_GEMM; ++rp) GEMM_WIN();
        if (TAIL_CONV && l + 1 < DEPTH) CONV_TAIL((l + 1) * PER_LAYER, (l + 1) * PER_LAYER + 2 * I_G, (M / 256) * (NIN / 256));
        GSYNC();
        PH(6) for (int rp = 0; rp < REP_ATTN; ++rp) attn_phase((char*)lds, (const attn_body::bf16*)PB, (attn_body::bf16*)OB, INP(12) + l * 8, SSQ, INP(10) + l * 64, INP(11) + l * 64, lsg(vcu), lsg(G), MYTID());
        GSYNC();
        PH(8) for (int rp = 0; rp < REP_GEMM; ++rp) GEMM_WOUT();
        GSYNC();
        PH(9) E_POST(INP(8) + l * DM, 1.0f, false);
        GSYNC();
        PH(10) for (int rp = 0; rp < REP_GU; ++rp) GEMM_SWIGLU(W_GU2);
        if (TAIL_CONV && l + 1 < DEPTH) CONV_TAIL((l + 1) * PER_LAYER + 2 * I_G, (l + 2) * PER_LAYER, (M / 256) * (2 * DFF / 256));
        GSYNC();
        PH(11) { GEMM_PLAIN(HB, W_D2, DM, DFF, YB, YLD); if (REP_DN == 2) GEMM_PLAIN(HB, W_D2, DM, DFF, YB, YLD); }
        GSYNC();
        if (l + 1 < DEPTH) { PH(12) E_POST(INP(17) + l * DM, 0.5f, false); GSYNC(); }
        else { PH(12) E_POST(INP(17) + l * DM, 0.5f, true); }
    }
}

#undef ws
#undef xout
#undef XB
#undef HB
#undef PB
#undef OB
#undef RSX
#undef SSQ
#undef YB
#undef wl
#undef lane
#undef MYTID
#undef TI_DECODE
#undef CONV_RANGE
#undef CONV_TAIL
extern "C" void kernel_launch(void* const* d_in, const int* in_sizes, int n_in, void* d_out, int out_size, void* d_ws, size_t ws_size, hipStream_t stream) {
    static int grid = 0;
    if (grid == 0) {
        if (n_in != 21 || out_size != M * DM || ws_size < WS_END) { fprintf(stderr, "kernel_launch: unexpected shapes (n_in %d out %d ws %zu)\n", n_in, out_size, ws_size); grid = -1; return; }
        int dev = 0, cus = 0, per_cu = 0;
        hipGetDevice(&dev); hipDeviceGetAttribute(&cus, hipDeviceAttributeMultiprocessorCount, dev);
        hipFuncSetAttribute((const void*)mega_fwd, hipFuncAttributeMaxDynamicSharedMemorySize, LDS_BYTES);
        if (hipOccupancyMaxActiveBlocksPerMultiprocessor(&per_cu, (const void*)mega_fwd, NWAVES * 64, LDS_BYTES) != hipSuccess || per_cu < 1) per_cu = 1;
        (void)hipGetLastError();
        grid = cus * per_cu;
    }
    if (grid < 0) return;
    if (hipMemsetAsync((char*)d_ws + WS_CTL, 0, CTL_BYTES, stream) != hipSuccess) { fprintf(stderr, "kernel_launch: memset of the barrier words failed\n"); return; }
    Args a{};
    for (int i = 0; i < 21; ++i) a.in[i] = (const float*)d_in[i];
    a.out = (float*)d_out; a.ws = (unsigned char*)d_ws;
    void* kargs[] = {&a};
    hipError_t e = hipLaunchCooperativeKernel((const void*)mega_fwd, dim3(grid), dim3(NWAVES * 64), kargs, LDS_BYTES, stream);
    if (e != hipSuccess) fprintf(stderr, "cooperative launch failed: %s (grid %d)\n", hipGetErrorString(e), grid);
}
```

```cpp
#include <hip/hip_runtime.h>
#include <cstdio>
#include <cstdint>
#ifndef PG8_WGM
#define PG8_WGM 8
#endif
namespace pg8 {
#define PG8_LAS __attribute__((address_space(3)))
typedef unsigned short bf16_t;
typedef short bf16x8 __attribute__((ext_vector_type(8)));
typedef float f32x4 __attribute__((ext_vector_type(4)));
typedef unsigned u32x4 __attribute__((ext_vector_type(4)));
constexpr int BM = 256, BK = 64, HALF = 128, HTB = HALF * BK * 2  , STAGE_BYTES = 8 * HTB, NXCD = 8, WGM = PG8_WGM;

__host__ __device__ __forceinline__ int lds_byte(int r, int c) { const int st = (r >> 4) * 2 + (c >> 5), rr = r & 15, cc = c & 31, ob = rr * 64 + cc * 2; return st * 1024 + (ob ^ (((ob >> 9) & 1) << 5)); }
__host__ __device__ __forceinline__ void stage_rc(int b, int& R, int& C) { const int st = b / 1024, sb = b % 1024, swz = sb ^ (((sb >> 9) & 1) << 5); R = (st >> 1) * 16 + swz / 64; C = (st & 1) * 32 + (swz % 64) / 2; }
__host__ __device__ __forceinline__ int perm32(int rho) { const int n = rho >> 4, i = rho & 15; return 8 * (i >> 2) + 4 * n + (i & 3); }

struct Unit { int pm, pn; };
struct Gemm { const bf16_t* A; const bf16_t* Bt; int M, N, K; };

struct StaticOrder {
    int nM, nN, nwg, G, c, nfull, rev;
    __host__ __device__ void init(int M, int N, int G_, int c_, bool half_tail = false, bool rev_ = false) { nM = M / BM; nN = N / BM; nwg = nM * nN; G = G_; c = c_; nfull = nwg; rev = rev_ ? 1 : 0;
        if (half_tail) { const int f = (nwg / G) * G; if ((G & 1) == 0 && (nwg - f) * 2 == G) nfull = f; } }
    __host__ __device__ void map(int L, Unit& u) const {
        int wgid = L; { const int q = nwg / NXCD, r = nwg % NXCD, xcd = wgid % NXCD, off = wgid / NXCD; wgid = (xcd < r ? xcd * (q + 1) : r * (q + 1) + (xcd - r) * q) + off; }
        const int nig = WGM * nN, gid = wgid / nig, fm = gid * WGM, gsz = (nM - fm) < WGM ? (nM - fm) : WGM;
        u.pm = fm + ((wgid % nig) % gsz); u.pn = (wgid % nig) / gsz; if (rev) u.pm = nM - 1 - u.pm; }
    __host__ __device__ bool half_unit(Unit& u, int& h) const { if (nfull == nwg) return false; map(nfull + (c >> 1), u); h = c & 1; return true; }
    __host__ __device__ bool next(int i, Unit& u) const {
        const long L = (long)i * G + c; if (L >= nfull) return false;
        map((int)L, u); return true;
    }
    __device__ __forceinline__ void a_ready(const Unit&) const {}
    __device__ __forceinline__ void done(const Unit&) const {}
};

__device__ __forceinline__ unsigned cvt_pk_bf16(float lo, float hi) { unsigned r; asm volatile("v_cvt_pk_bf16_f32 %0, %1, %2" : "=v"(r) : "v"(lo), "v"(hi)); return r; }
__device__ __forceinline__ float silu_mul(float g, float u, float c1, float c2) { const float e = __builtin_amdgcn_exp2f(g * c1); return (g * u) * (c2 * __builtin_amdgcn_rcpf(1.0f + e)); }
struct EpiSwiGLU {
    static constexpr bool PERM = true, AFTER_DRAIN = false, MIDSCALE = false, PREFETCH = false, HALF_TAIL = false;
    __device__ __forceinline__ void half(const f32x4 (&acc)[2][2][4][2], const Unit& u, int hh, int wr, int wc, int fr, int fq) const {
        unsigned lrow = (unsigned)(hh * HALF + wr * 64 + fr); asm volatile("" : "+v"(lrow)); const float* rb = rsx + u.pm * BM;
        bf16_t* obase = O + (size_t)u.pm * BM * ldc + u.pn * HALF + wc * 32 + 8 * fq;
#pragma unroll
        for (int m = 0; m < 4; ++m) { const unsigned lr = lrow + (unsigned)(m * 16); const float rs = rb[lr], c1 = rs * -1.4426950408889634f, c2 = rs * rs;
            const f32x4 g0 = acc[0][0][m][0], g1 = acc[0][0][m][1], u0 = acc[0][1][m][0], u1 = acc[0][1][m][1];
            u32x4 w; w.x = cvt_pk_bf16(silu_mul(g0[0], u0[0], c1, c2), silu_mul(g0[1], u0[1], c1, c2)); w.y = cvt_pk_bf16(silu_mul(g0[2], u0[2], c1, c2), silu_mul(g0[3], u0[3], c1, c2));
            w.z = cvt_pk_bf16(silu_mul(g1[0], u1[0], c1, c2), silu_mul(g1[1], u1[1], c1, c2)); w.w = cvt_pk_bf16(silu_mul(g1[2], u1[2], c1, c2), silu_mul(g1[3], u1[3], c1, c2));
            *(u32x4*)(obase + (size_t)lr * ldc) = w; }
    }
    bf16_t* O; int ldc; const float* rsx;
    __device__ __forceinline__ void prefetch(const Unit& u, int wr, int fr, float (&rsv)[2][4]) const {
        unsigned lrow = (unsigned)(wr * 64 + fr); asm volatile("" : "+v"(lrow)); const float* rb = rsx + u.pm * BM;
#pragma unroll
        for (int ai = 0; ai < 2; ++ai)
#pragma unroll
            for (int m = 0; m < 4; ++m) rsv[ai][m] = rb[lrow + (unsigned)(ai * HALF + m * 16)];
    }
    __device__ __forceinline__ void operator()(const f32x4 (&acc)[2][2][4][2], const Unit& u, int wr, int wc, int fr, int fq) const {
        const int row0 = u.pm * BM + wr * 64 + fr; const int col0 = u.pn * HALF + wc * 32 + 8 * fq;
        float rsv[2][4]; prefetch(u, wr, fr, rsv);
#pragma unroll
        for (int ai = 0; ai < 2; ++ai)
#pragma unroll
            for (int m = 0; m < 4; ++m) { bf16_t* rowp = O + (size_t)(row0 + ai * HALF + m * 16) * ldc + col0;
                const float rs = rsv[ai][m], c1 = rs * -1.4426950408889634f, c2 = rs * rs; const f32x4 g0 = acc[ai][0][m][0], g1 = acc[ai][0][m][1], u0 = acc[ai][1][m][0], u1 = acc[ai][1][m][1];
                u32x4 w; w.x = cvt_pk_bf16(silu_mul(g0[0], u0[0], c1, c2), silu_mul(g0[1], u0[1], c1, c2)); w.y = cvt_pk_bf16(silu_mul(g0[2], u0[2], c1, c2), silu_mul(g0[3], u0[3], c1, c2));
                w.z = cvt_pk_bf16(silu_mul(g1[0], u1[0], c1, c2), silu_mul(g1[1], u1[1], c1, c2)); w.w = cvt_pk_bf16(silu_mul(g1[2], u1[2], c1, c2), silu_mul(g1[3], u1[3], c1, c2));
                *(u32x4*)rowp = w; }
    }
};
struct EpiPlain {
    static constexpr bool PERM = true, AFTER_DRAIN = false, MIDSCALE = false, PREFETCH = false, HALF_TAIL = false;
    bf16_t* O; int ldc; int sc_lo, sc_hi; float scv;
    __device__ __forceinline__ void operator()(const f32x4 (&acc)[2][2][4][2], const Unit& u, int wr, int wc, int fr, int fq) const {
        const int row0 = u.pm * BM + wr * 64 + fr; const int col0 = u.pn * BM + wc * 32 + 8 * fq;
        const float sc = (u.pn >= sc_lo && u.pn < sc_hi) ? scv : 1.0f;
#pragma unroll
        for (int ai = 0; ai < 2; ++ai)
#pragma unroll
            for (int m = 0; m < 4; ++m) { bf16_t* rowp = O + (size_t)(row0 + ai * HALF + m * 16) * ldc + col0;
#pragma unroll
                for (int bj = 0; bj < 2; ++bj) { const f32x4 v0 = acc[ai][bj][m][0] * sc, v1 = acc[ai][bj][m][1] * sc;
                    u32x4 w; w.x = cvt_pk_bf16(v0[0], v0[1]); w.y = cvt_pk_bf16(v0[2], v0[3]); w.z = cvt_pk_bf16(v1[0], v1[1]); w.w = cvt_pk_bf16(v1[2], v1[3]);
                    *(u32x4*)(rowp + bj * HALF) = w; } }
    }
};


struct EpiWin {
    static constexpr bool PERM = true, AFTER_DRAIN = false, MIDSCALE = false, PREFETCH = false, HALF_TAIL = false;
    bf16_t* O; const float* rsx; const float* gq; const float* gk; float qscale;
    __device__ __forceinline__ void operator()(const f32x4 (&acc)[2][2][4][2], const Unit& u, int wr, int wc, int fr, int fq) const {
        const int hc = u.pn * BM + wc * 64;
        unsigned lrow = (unsigned)(wr * 64 + fr); asm volatile("" : "+v"(lrow));
        unsigned loff = lrow * 1536u + (unsigned)(wc * 64 + 8 * fq);
        bf16_t* obase = O + (size_t)u.pm * BM * 1536 + u.pn * BM;
        const float* rbase = rsx + u.pm * BM; const int trow0 = u.pm * BM;
        if (hc < 640) {
            const float* gp = (hc < 512) ? gq : gk; const float osc = (hc < 512) ? qscale : 1.0f;
            f32x4 gg[2][2]; float invf[2][2];
#pragma unroll
            for (int bj = 0; bj < 2; ++bj)
#pragma unroll
                for (int n = 0; n < 2; ++n) gg[bj][n] = *(const f32x4*)(gp + 32 * bj + 8 * fq + 4 * n);
#pragma unroll
            for (int n = 0; n < 2; ++n)
#pragma unroll
                for (int jj = 0; jj < 2; ++jj) invf[n][jj] = __builtin_amdgcn_exp2f((float)(4 * fq + 2 * n + jj) * -0.83048202372184058696f) * 0.15915494309189533577f;
#pragma unroll
            for (int ai = 0; ai < 2; ++ai)
#pragma unroll
                for (int m = 0; m < 4; ++m) {
                    const unsigned lr = lrow + (unsigned)(ai * HALF + m * 16); const int row = trow0 + (int)lr; const int t = (row < 32768) ? (row & 16383) : (row & 8191);
                    const float rs = rbase[lr]; float pos[2]; pos[0] = (float)(t >> 6); pos[1] = (float)(t & 63);
                    f32x4 v[2][2]; float ss = 0.f;
#pragma unroll
                    for (int bj = 0; bj < 2; ++bj)
#pragma unroll
                        for (int n = 0; n < 2; ++n) { v[bj][n] = acc[ai][bj][m][n] * rs; ss += (v[bj][n][0] * v[bj][n][0] + v[bj][n][1] * v[bj][n][1]) + (v[bj][n][2] * v[bj][n][2] + v[bj][n][3] * v[bj][n][3]); }
                    ss += __shfl_xor(ss, 16); ss += __shfl_xor(ss, 32);
                    const float rstd = __builtin_amdgcn_rsqf(ss * (1.0f / 64.0f) + 1e-6f);
#pragma unroll
                    for (int bj = 0; bj < 2; ++bj) { float o[8];
#pragma unroll
                        for (int n = 0; n < 2; ++n) { const f32x4 x = v[bj][n] * rstd * gg[bj][n];
#pragma unroll
                            for (int jj = 0; jj < 2; ++jj) { float rev = pos[bj] * invf[n][jj]; rev = rev - __builtin_floorf(rev);
                                const float sn = __builtin_amdgcn_sinf(rev), cs = __builtin_amdgcn_cosf(rev); const float x0 = x[2 * jj], x1 = x[2 * jj + 1];
                                o[4 * n + 2 * jj] = (x0 * cs - x1 * sn) * osc; o[4 * n + 2 * jj + 1] = (x0 * sn + x1 * cs) * osc; } }
                        u32x4 w; w.x = cvt_pk_bf16(o[0], o[1]); w.y = cvt_pk_bf16(o[2], o[3]); w.z = cvt_pk_bf16(o[4], o[5]); w.w = cvt_pk_bf16(o[6], o[7]);
                        *(u32x4*)(obase + (loff + (unsigned)((ai * HALF + m * 16) * 1536 + 32 * bj))) = w; }
                    asm volatile("" ::: "memory"); __builtin_amdgcn_sched_barrier(0);
                }
        } else {
            const float sc = (hc >= 768 && hc < 1280) ? qscale : 1.0f;
#pragma unroll
            for (int ai = 0; ai < 2; ++ai)
#pragma unroll
                for (int m = 0; m < 4; ++m) { const unsigned lr = lrow + (unsigned)(ai * HALF + m * 16); const float rs = rbase[lr] * sc;
#pragma unroll
                    for (int bj = 0; bj < 2; ++bj) { const f32x4 v0 = acc[ai][bj][m][0] * rs, v1 = acc[ai][bj][m][1] * rs;
                        u32x4 w; w.x = cvt_pk_bf16(v0[0], v0[1]); w.y = cvt_pk_bf16(v0[2], v0[3]); w.z = cvt_pk_bf16(v1[0], v1[1]); w.w = cvt_pk_bf16(v1[2], v1[3]);
                        *(u32x4*)(obase + (loff + (unsigned)((ai * HALF + m * 16) * 1536 + 32 * bj))) = w; } }
        }
    }
};


struct EpiOutNorm {
    static constexpr bool PERM = true, AFTER_DRAIN = false, MIDSCALE = true, PREFETCH = false, HALF_TAIL = false;
    bf16_t* O; int ldc; const float* ssq;
    __device__ __forceinline__ void mid(f32x4 (&acc)[2][2][4][2], const Unit& u, int wr, int fr, float (&rbv)[2][4]) const {
        unsigned lrow = (unsigned)(wr * 64 + fr); asm volatile("" : "+v"(lrow));
        const float* sb = ssq + (size_t)u.pm * BM * 16;
#pragma unroll
        for (int ai = 0; ai < 2; ++ai)
#pragma unroll
            for (int m = 0; m < 4; ++m) { const f32x4* p = (const f32x4*)(sb + (lrow + (unsigned)(ai * HALF + m * 16)) * 16u);
                const f32x4 a0 = p[0], a1 = p[1], b0 = p[2], b1 = p[3];
                const float sa = ((a0[0] + a0[1]) + (a0[2] + a0[3])) + ((a1[0] + a1[1]) + (a1[2] + a1[3])), sb2 = ((b0[0] + b0[1]) + (b0[2] + b0[3])) + ((b1[0] + b1[1]) + (b1[2] + b1[3]));
                const float ra = __builtin_amdgcn_rsqf(sa * (1.0f / 512.0f) + 1e-6f), rb = __builtin_amdgcn_rsqf(sb2 * (1.0f / 512.0f) + 1e-6f);
                rbv[ai][m] = rb; const float ratio = ra * __builtin_amdgcn_rcpf(rb);
#pragma unroll
                for (int bj = 0; bj < 2; ++bj)
#pragma unroll
                    for (int n = 0; n < 2; ++n) acc[ai][bj][m][n] = acc[ai][bj][m][n] * ratio; }
    }
    __device__ __forceinline__ void operator()(const f32x4 (&acc)[2][2][4][2], const Unit& u, int wr, int wc, int fr, int fq, const float (&rbv)[2][4]) const {
        const int row0 = u.pm * BM + wr * 64 + fr; const int col0 = u.pn * BM + wc * 32 + 8 * fq;
#pragma unroll
        for (int ai = 0; ai < 2; ++ai)
#pragma unroll
            for (int m = 0; m < 4; ++m) { bf16_t* rowp = O + (size_t)(row0 + ai * HALF + m * 16) * ldc + col0; const float sc = rbv[ai][m];
#pragma unroll
                for (int bj = 0; bj < 2; ++bj) { const f32x4 v0 = acc[ai][bj][m][0] * sc, v1 = acc[ai][bj][m][1] * sc;
                    u32x4 w; w.x = cvt_pk_bf16(v0[0], v0[1]); w.y = cvt_pk_bf16(v0[2], v0[3]); w.z = cvt_pk_bf16(v1[0], v1[1]); w.w = cvt_pk_bf16(v1[2], v1[3]);
                    *(u32x4*)(rowp + bj * HALF) = w; } }
    }
};

template <class Epi, class Sched, bool ALIGN_EPI = false, bool SP2 = false>
__device__ __forceinline__ void gemm_phase(PG8_LAS unsigned char* lds, const Gemm g, const Sched& S, const Epi& E, int tid_in) {
    int tid_ = tid_in; asm volatile("" : "+v"(tid_)); const int tid = tid_, wid = __builtin_amdgcn_readfirstlane(tid >> 6), lane = tid & 63, wr = wid >> 2, wc = wid & 3, fr = lane & 15, fq = lane >> 4;
    const int K = g.K, nt = K / BK;
    unsigned voffA[2], voffB[2];
#pragma unroll
    for (int i = 0; i < 2; ++i) { int R, C; stage_rc(tid * 16 + i * 8192, R, C); const int Rb = Epi::PERM ? ((R & ~31) + perm32(R & 31)) : R;
        voffA[i] = (unsigned)(R * K + C) * 2u; voffB[i] = (unsigned)(Rb * K + C) * 2u; }
    const size_t kstep = (size_t)(BK * 2);
    const size_t hstep = (size_t)HALF * K * 2;
    const size_t tstep = 2 * hstep;
    const unsigned ldsw = (unsigned)wid * 1024u;
    const int aoff = lds_byte(wr * 64 + fr, fq * 8), boff = lds_byte(wc * 32 + fr, fq * 8);
#define PG8_SA(b, h) (((b) * 2 + (h)) * HTB)
#define PG8_SB(b, h) ((4 + (b) * 2 + (h)) * HTB)
#define PG8_STAGE(bufoff, gbase, voff) do { _Pragma("unroll") for (int _i = 0; _i < 2; ++_i) \
        __builtin_amdgcn_global_load_lds((const unsigned*)((const char*)(gbase) + (voff)[_i]), (PG8_LAS unsigned*)(lds + (bufoff) + ldsw + _i * 8192), 16, 0, 0); } while (0)
#define PG8_LDA(dst, b, h) do { _Pragma("unroll") for (int m = 0; m < 4; ++m) _Pragma("unroll") for (int k = 0; k < 2; ++k) dst[m][k] = *(const PG8_LAS bf16x8*)(lds + PG8_SA(b, h) + aoff + m * 2048 + k * 1024); } while (0)
#define PG8_LDB(dst, b, h) do { _Pragma("unroll") for (int n = 0; n < 2; ++n) _Pragma("unroll") for (int k = 0; k < 2; ++k) dst[n][k] = *(const PG8_LAS bf16x8*)(lds + PG8_SB(b, h) + boff + n * 2048 + k * 1024); } while (0)
#define PG8_MMA(ai, bj, At, Bt) do { __builtin_amdgcn_s_setprio(1); _Pragma("unroll") for (int m = 0; m < 4; ++m) _Pragma("unroll") for (int n = 0; n < 2; ++n) _Pragma("unroll") for (int k = 0; k < 2; ++k) \
        acc[ai][bj][m][n] = __builtin_amdgcn_mfma_f32_16x16x32_bf16(Bt[n][k], At[m][k], acc[ai][bj][m][n], 0, 0, 0); __builtin_amdgcn_s_setprio(0); } while (0)
#define PG8_WAIT_V(n) asm volatile("s_waitcnt vmcnt(" #n ")" ::: "memory")
#define PG8_WAIT_L(n) asm volatile("s_waitcnt lgkmcnt(" #n ")" ::: "memory")
#define PG8_BAR __builtin_amdgcn_s_barrier()
#define PG8_SCHED __builtin_amdgcn_sched_barrier(0)
    Unit cur, nxt; int ui = 0;
    if (!S.next(0, cur)) return;
    f32x4 acc[2][2][4][2]; float midst[2][4];
#pragma unroll
    for (int a = 0; a < 2; ++a)
#pragma unroll
        for (int b = 0; b < 2; ++b)
#pragma unroll
            for (int m = 0; m < 4; ++m)
#pragma unroll
                for (int n = 0; n < 2; ++n) acc[a][b][m][n] = (f32x4){0.f, 0.f, 0.f, 0.f};
    bf16x8 At[4][2], B0[2][2], B1[2][2];
    const char* cA = (const char*)g.A + (size_t)cur.pm * tstep; const char* cB = (const char*)g.Bt + (size_t)cur.pn * tstep;
    S.a_ready(cur);
    if constexpr (SP2) {
        PG8_STAGE(PG8_SB(0, 0), cB, voffB); PG8_STAGE(PG8_SB(0, 1), cB + hstep, voffB); PG8_STAGE(PG8_SA(0, 0), cA, voffA); PG8_STAGE(PG8_SA(0, 1), cA + hstep, voffA);
        if (wr == 1) PG8_BAR;
        PG8_WAIT_V(2); PG8_BAR;
        PG8_STAGE(PG8_SB(1, 0), cB + kstep, voffB); PG8_STAGE(PG8_SB(1, 1), cB + hstep + kstep, voffB);
        PG8_WAIT_V(4); PG8_BAR;
    } else {
        PG8_STAGE(PG8_SB(0, 0), cB, voffB); PG8_STAGE(PG8_SA(0, 0), cA, voffA); PG8_STAGE(PG8_SB(0, 1), cB + hstep, voffB); PG8_STAGE(PG8_SA(0, 1), cA + hstep, voffA);
        if (wr == 1) PG8_BAR;
        PG8_WAIT_V(4); PG8_BAR;
        PG8_STAGE(PG8_SB(1, 0), cB + kstep, voffB); PG8_STAGE(PG8_SA(1, 0), cA + kstep, voffA); PG8_STAGE(PG8_SB(1, 1), cB + hstep + kstep, voffB);
        PG8_WAIT_V(6); PG8_BAR;
    }
    for (;;) {
        const bool has_next = S.next(ui + 1, nxt);
        const char* nA = has_next ? (const char*)g.A + (size_t)nxt.pm * tstep : cA; const char* nB = has_next ? (const char*)g.Bt + (size_t)nxt.pn * tstep : cB;
        for (int t = 0; t < nt; t += 2) {
            if constexpr (Epi::MIDSCALE) { if (t == (nt >> 1)) E.mid(acc, cur, wr, fr, midst); }
            if constexpr (Epi::PREFETCH) { if (t == nt - 2) E.prefetch(cur, wr, fr, midst); }
            const bool last = (t == nt - 2);
            const char* a1 = cA + (size_t)(t + 1) * kstep;
            const char* a2 = last ? nA : cA + (size_t)(t + 2) * kstep; const char* b2 = last ? nB : cB + (size_t)(t + 2) * kstep;
            const char* a3 = a2 + kstep; const char* b3 = b2 + kstep;
            if (last && has_next) S.a_ready(nxt);
            if constexpr (SP2) {
            PG8_LDB(B0, 0, 0); PG8_LDB(B1, 0, 1); PG8_SCHED; PG8_LDA(At, 0, 0); PG8_STAGE(PG8_SA(1, 0), a1, voffA); PG8_STAGE(PG8_SA(1, 1), a1 + hstep, voffA);
            PG8_WAIT_V(8); PG8_WAIT_L(0); PG8_BAR; PG8_MMA(0, 0, At, B0); PG8_MMA(0, 1, At, B1); PG8_BAR; PG8_SCHED;
            PG8_LDA(At, 0, 1); PG8_STAGE(PG8_SB(0, 0), b2, voffB); PG8_STAGE(PG8_SB(0, 1), b2 + hstep, voffB);
            PG8_WAIT_V(6); PG8_WAIT_L(0); PG8_BAR; PG8_MMA(1, 0, At, B0); PG8_MMA(1, 1, At, B1); PG8_BAR; PG8_SCHED;
            PG8_LDB(B0, 1, 0); PG8_LDB(B1, 1, 1); PG8_SCHED; PG8_LDA(At, 1, 0); PG8_STAGE(PG8_SA(0, 0), a2, voffA); PG8_STAGE(PG8_SA(0, 1), a2 + hstep, voffA);
            PG8_WAIT_V(8); PG8_WAIT_L(0); PG8_BAR; PG8_MMA(0, 0, At, B0); PG8_MMA(0, 1, At, B1); PG8_BAR; PG8_SCHED;
            PG8_LDA(At, 1, 1); PG8_STAGE(PG8_SB(1, 0), b3, voffB); PG8_STAGE(PG8_SB(1, 1), b3 + hstep, voffB);
            PG8_WAIT_V(6); PG8_WAIT_L(0); PG8_BAR; PG8_MMA(1, 0, At, B0); PG8_MMA(1, 1, At, B1); PG8_BAR; PG8_SCHED;
            } else {
            PG8_LDB(B0, 0, 0); PG8_SCHED; PG8_LDA(At, 0, 0); PG8_STAGE(PG8_SA(1, 1), a1 + hstep, voffA);
            PG8_WAIT_L(8); PG8_BAR; PG8_WAIT_L(0); PG8_MMA(0, 0, At, B0); PG8_BAR; PG8_SCHED;
            PG8_LDB(B1, 0, 1); PG8_STAGE(PG8_SB(0, 0), b2, voffB);
            PG8_BAR; PG8_WAIT_L(0); PG8_MMA(0, 1, At, B1); PG8_BAR;
            PG8_LDA(At, 0, 1); PG8_STAGE(PG8_SA(0, 0), a2, voffA);
            PG8_BAR; PG8_WAIT_L(0); PG8_MMA(1, 0, At, B0); PG8_BAR; PG8_SCHED;
            PG8_STAGE(PG8_SB(0, 1), b2 + hstep, voffB);
            PG8_WAIT_V(6); PG8_BAR; PG8_MMA(1, 1, At, B1); PG8_BAR;
            PG8_LDB(B0, 1, 0); PG8_SCHED; PG8_LDA(At, 1, 0); PG8_STAGE(PG8_SA(0, 1), a2 + hstep, voffA);
            PG8_WAIT_L(8); PG8_BAR; PG8_WAIT_L(0); PG8_MMA(0, 0, At, B0); PG8_BAR; PG8_SCHED;
            PG8_LDB(B1, 1, 1); PG8_STAGE(PG8_SB(1, 0), b3, voffB);
            PG8_BAR; PG8_WAIT_L(0); PG8_MMA(0, 1, At, B1); PG8_BAR;
            PG8_LDA(At, 1, 1); PG8_STAGE(PG8_SA(1, 0), a3, voffA);
            PG8_BAR; PG8_WAIT_L(0); PG8_MMA(1, 0, At, B0); PG8_BAR; PG8_SCHED;
            PG8_STAGE(PG8_SB(1, 1), b3 + hstep, voffB);
            PG8_WAIT_V(6); PG8_BAR; PG8_MMA(1, 1, At, B1); PG8_BAR;
            }
        }
        if constexpr (ALIGN_EPI) { if (wr == 0) PG8_BAR; }
        if constexpr (!Epi::AFTER_DRAIN) { if constexpr (Epi::MIDSCALE || Epi::PREFETCH) E(acc, cur, wr, wc, fr, fq, midst); else E(acc, cur, wr, wc, fr, fq); S.done(cur); }
        if (!has_next) break;
#pragma unroll
        for (int a = 0; a < 2; ++a)
#pragma unroll
            for (int b = 0; b < 2; ++b)
#pragma unroll
                for (int m = 0; m < 4; ++m)
#pragma unroll
                    for (int n = 0; n < 2; ++n) acc[a][b][m][n] = (f32x4){0.f, 0.f, 0.f, 0.f};
        cur = nxt; cA = nA; cB = nB; ++ui;
        if constexpr (ALIGN_EPI) { if (wr == 1) PG8_BAR; }
    }
    PG8_WAIT_V(0);
    if constexpr (!ALIGN_EPI) { if (wr == 0) PG8_BAR; }
    PG8_BAR;
    if constexpr (Epi::AFTER_DRAIN) { E.fused(acc, cur, wr, wc, fr, fq, lds, wid, lane); S.done(cur); }
    if constexpr (Epi::HALF_TAIL) {
        Unit hu; int hh;
        if (S.half_unit(hu, hh)) {
            const char* hA = (const char*)g.A + (size_t)hu.pm * tstep + (size_t)hh * hstep; const char* hB = (const char*)g.Bt + (size_t)hu.pn * tstep;
#pragma unroll
            for (int b = 0; b < 2; ++b)
#pragma unroll
                for (int m = 0; m < 4; ++m)
#pragma unroll
                    for (int n = 0; n < 2; ++n) acc[0][b][m][n] = (f32x4){0.f, 0.f, 0.f, 0.f};
#define HS_STAGE(s_, kt_) do { const int so_ = (s_) * 3 * HTB; const size_t ko_ = (size_t)(kt_) * kstep; PG8_STAGE(so_, hA + ko_, voffA); PG8_STAGE(so_ + HTB, hB + ko_, voffB); PG8_STAGE(so_ + 2 * HTB, hB + hstep + ko_, voffB); } while (0)
            HS_STAGE(0, 0); HS_STAGE(1, 1);
            int st = 0;
            for (int t = 0; t < nt; ++t) {
                if (t + 1 < nt) PG8_WAIT_V(6); else PG8_WAIT_V(0);
                PG8_BAR;
                if (t + 2 < nt) { const int s2 = (st >= 1) ? st - 1 : 2; HS_STAGE(s2, t + 2); }
                const int so = st * 3 * HTB;
#pragma unroll
                for (int n = 0; n < 2; ++n)
#pragma unroll
                    for (int k = 0; k < 2; ++k) { B0[n][k] = *(const PG8_LAS bf16x8*)(lds + so + HTB + boff + n * 2048 + k * 1024); B1[n][k] = *(const PG8_LAS bf16x8*)(lds + so + 2 * HTB + boff + n * 2048 + k * 1024); }
#pragma unroll
                for (int m = 0; m < 4; ++m)
#pragma unroll
                    for (int k = 0; k < 2; ++k) At[m][k] = *(const PG8_LAS bf16x8*)(lds + so + aoff + m * 2048 + k * 1024);
                PG8_WAIT_L(0);
                PG8_MMA(0, 0, At, B0); PG8_MMA(0, 1, At, B1);
                st = (st == 2) ? 0 : st + 1;
            }
            PG8_BAR;
#undef HS_STAGE
            E.half(acc, hu, hh, wr, wc, fr, fq);
        }
    }
#undef PG8_SA
#undef PG8_SB
#undef PG8_STAGE
#undef PG8_LDA
#undef PG8_LDB
#undef PG8_MMA
#undef PG8_WAIT_V
#undef PG8_WAIT_L
#undef PG8_BAR
#undef PG8_SCHED
}
}

#ifndef PG8_SP2
#define PG8_SP2 true
#endif
#ifndef PG8_ALIGN
#define PG8_ALIGN true
#endif
#include <hip/hip_bf16.h>
#include <cmath>
namespace attn_body {
using bf16=__hip_bfloat16;
using bf16x8=__attribute__((ext_vector_type(8)))short;
using s16x4=__attribute__((ext_vector_type(4)))short;
using f32x16=__attribute__((ext_vector_type(16)))float;
using u32x4=__attribute__((ext_vector_type(4)))unsigned;
constexpr int D=64,PITCH=1536,OPITCH=1024;
constexpr int NW=8,QBLK=32,QB=QBLK*NW,KVBLK=64;
__device__ __forceinline__ int crow(int r,int hi){return (r&3)+8*(r>>2)+4*hi;}
#define SBAR() __builtin_amdgcn_sched_barrier(0)
__device__ __forceinline__ void cmask(f32x16&p0,f32x16&p1,int jb,int qrel,int hi){
  const float NEG=-INFINITY; int kb=64*jb+4*hi;
  #pragma unroll
  for(int r=0;r<16;++r){int kv=kb+(r&3)+8*(r>>2); if(kv>qrel)p0[r]=NEG; if(kv+32>qrel)p1[r]=NEG;}
}

__device__ __forceinline__ void wmask(f32x16&p0,f32x16&p1,float fb,float slope2){
  const float NEG=-INFINITY;
  #pragma unroll
  for(int r=0;r<16;++r){ const float c=(float)((r&3)+8*(r>>2)); const float a0=__builtin_fabsf(fb-c), a1=__builtin_fabsf(fb-c-32.f);
    p0[r]=(a0<=128.f)?(p0[r]-slope2*a0):NEG; p1[r]=(a1<=128.f)?(p1[r]-slope2*a1):NEG; }
}
constexpr int NSLOT=5, SLOTB=8192;
constexpr int LDS_K=0, LDS_V=NSLOT*SLOTB, LDS_WS=2*NSLOT*SLOTB, LDS_OST=LDS_WS+NW*64*4, LDS_BYTES=LDS_OST+NW*4096;
constexpr float C2=0.125f*1.4426950408889634f;
__device__ __forceinline__ void glds16(const void*gsrc,unsigned lds_dst){unsigned keep;
  asm volatile("s_mov_b32 %0, m0\n\ts_mov_b32 m0, %2\n\ts_nop 0\n\tglobal_load_lds_dwordx4 %1, off\n\ts_mov_b32 m0, %0":"=&s"(keep):"v"(gsrc),"s"(lds_dst):"memory");}
__device__ __forceinline__ float max3f(float a,float b,float c){float r;asm("v_max3_f32 %0, %1, %2, %3":"=v"(r):"v"(a),"v"(b),"v"(c));return r;}
__device__ __forceinline__ float max2f(float a,float b){float r;asm("v_max_f32_e32 %0, %1, %2":"=v"(r):"v"(a),"v"(b));return r;}
__device__ __forceinline__ float fadd_s(float a,float b){float r;asm("v_add_f32_e32 %0, %1, %2":"=v"(r):"v"(a),"v"(b));return r;}
__device__ __forceinline__ float fsub_s(float a,float b){float r;asm("v_sub_f32_e32 %0, %1, %2":"=v"(r):"v"(a),"v"(b));return r;}
typedef float f32x2_t __attribute__((ext_vector_type(2))); typedef __bf16 bf16x2_t __attribute__((ext_vector_type(2)));
__device__ __forceinline__ unsigned cvtpk_s(float lo,float hi){f32x2_t v={lo,hi};bf16x2_t b=__builtin_convertvector(v,bf16x2_t);return __builtin_bit_cast(unsigned,b);}
#define WAIT_BAR(N) asm volatile("s_waitcnt vmcnt(" #N ") lgkmcnt(0)\n\ts_barrier":::"memory")

__device__ __forceinline__ void qkt(f32x16&p0,f32x16&p1,const char*Kslot,const bf16x8*qr,const f32x16&negm,int r32,int hi){
  const char*kb=Kslot+hi*1024+r32*16;
  #pragma unroll
  for(int d0=0;d0<4;++d0){
    const bf16x8 b0=*reinterpret_cast<const bf16x8*>(kb+d0*2048);
    const bf16x8 b1=*reinterpret_cast<const bf16x8*>(kb+d0*2048+512);
    if(d0==0){p0=__builtin_amdgcn_mfma_f32_32x32x16_bf16(b0,qr[0],negm,0,0,0);p1=__builtin_amdgcn_mfma_f32_32x32x16_bf16(b1,qr[0],negm,0,0,0);}
    else{p0=__builtin_amdgcn_mfma_f32_32x32x16_bf16(b0,qr[d0],p0,0,0,0);p1=__builtin_amdgcn_mfma_f32_32x32x16_bf16(b1,qr[d0],p1,0,0,0);}}
}
typedef __attribute__((address_space(3))) const char* lds_cptr;
typedef short v4i16_t __attribute__((ext_vector_type(4)));
__device__ __forceinline__ void kload8(bf16x8*kf,lds_cptr kp){
  kf[0]=*(const __attribute__((address_space(3))) bf16x8*)(kp);      kf[1]=*(const __attribute__((address_space(3))) bf16x8*)(kp+512);
  kf[2]=*(const __attribute__((address_space(3))) bf16x8*)(kp+2048); kf[3]=*(const __attribute__((address_space(3))) bf16x8*)(kp+2560);
  kf[4]=*(const __attribute__((address_space(3))) bf16x8*)(kp+4096); kf[5]=*(const __attribute__((address_space(3))) bf16x8*)(kp+4608);
  kf[6]=*(const __attribute__((address_space(3))) bf16x8*)(kp+6144); kf[7]=*(const __attribute__((address_space(3))) bf16x8*)(kp+6656);
}
__device__ __forceinline__ void kload2(bf16x8*kf,lds_cptr kp,int j){ kf[2*j]=*(const __attribute__((address_space(3))) bf16x8*)(kp+j*2048); kf[2*j+1]=*(const __attribute__((address_space(3))) bf16x8*)(kp+j*2048+512); }
__device__ __forceinline__ s16x4 vtr(lds_cptr p){ return __builtin_bit_cast(s16x4,__builtin_amdgcn_ds_read_tr16_b64_v4i16((__attribute__((address_space(3))) v4i16_t*)p)); }
__device__ __forceinline__ float rowmax(const f32x16&p0,const f32x16&p1){
  float a=max3f(p0[0],p0[1],p1[0]),b=max3f(p0[2],p0[3],p1[1]);a=max3f(a,p1[2],p1[3]);
  #pragma unroll
  for(int r=4;r<16;r+=4){a=max3f(a,p0[r],p0[r+1]);b=max3f(b,p0[r+2],p0[r+3]);a=max3f(a,p1[r],p1[r+1]);b=max3f(b,p1[r+2],p1[r+3]);}
  const float m=max2f(a,b);
  auto rr=__builtin_amdgcn_permlane32_swap(__float_as_uint(m),__float_as_uint(m),false,false);
  return max2f(__uint_as_float(rr[0]),__uint_as_float(rr[1]));
}
__device__ __forceinline__ void pv(f32x16*o,int vb,bf16x8 pa0,bf16x8 pa1,bf16x8 pa2,bf16x8 pa3){
  #pragma unroll
  for(int d0=0;d0<2;++d0){s16x4 lo[4],hi[4];
    #pragma unroll
    for(int ks=0;ks<4;++ks){
      asm volatile("ds_read_b64_tr_b16 %0,%1 offset:%c2":"=&v"(lo[ks]):"v"(vb),"i"(d0*4096+ks*1024):"memory");
      asm volatile("ds_read_b64_tr_b16 %0,%1 offset:%c2":"=&v"(hi[ks]):"v"(vb),"i"(d0*4096+ks*1024+512):"memory");}
    asm volatile("s_waitcnt lgkmcnt(0)":::"memory");SBAR();
    #define PK(k) (bf16x8){lo[k][0],lo[k][1],lo[k][2],lo[k][3],hi[k][0],hi[k][1],hi[k][2],hi[k][3]}
    o[d0]=__builtin_amdgcn_mfma_f32_32x32x16_bf16(pa0,PK(0),o[d0],0,0,0);
    o[d0]=__builtin_amdgcn_mfma_f32_32x32x16_bf16(pa1,PK(1),o[d0],0,0,0);
    o[d0]=__builtin_amdgcn_mfma_f32_32x32x16_bf16(pa2,PK(2),o[d0],0,0,0);
    o[d0]=__builtin_amdgcn_mfma_f32_32x32x16_bf16(pa3,PK(3),o[d0],0,0,0);
    #undef PK
  }
}
#ifndef ATTN_STORE16
#define ATTN_STORE16(p,v) (*(u32x4*)(p)=(v))
#endif
template<int MODE,int THRL,bool NOMAX> __device__ __forceinline__ void attn_unit(const bf16*Qs,const bf16*__restrict__ Ks,const bf16*__restrict__ Vs,bf16*Os,int S,int q0,float sink2,float slope2,float*ssq,char*shm,int tid_in){
  int tid_=tid_in; asm volatile("":"+v"(tid_)); const int tid=tid_,lane=tid&63,r32=lane&31,hi=lane>>5; const int wid=__builtin_amdgcn_readfirstlane(tid>>6);
  int kt0=0,kend=S/KVBLK;
  if(MODE==1){ kt0=(q0>=128?(q0-128):0)/KVBLK; const int ke=q0+QB+128; kend=(ke<S?ke:S)/KVBLK; }
  const bf16*Qw=Qs+(long)(q0+wid*QBLK)*PITCH;
  const bf16*Kh=Ks+(long)kt0*KVBLK*PITCH,*Vh=Vs+(long)kt0*KVBLK*PITCH;
  const unsigned lds0=(unsigned)(uintptr_t)shm;
  float*wsf=(float*)(shm+LDS_WS)+wid*64;
  const bf16*ksrc=Kh+(long)lane*PITCH+wid*8;
  const bf16*vsrc=Vh+(long)(16*(wid&3)+(lane>>2))*PITCH+(wid>>2)*32+(lane&3)*8;
  const unsigned kdst=lds0+LDS_K+wid*1024, vdst=lds0+LDS_V+wid*1024;
  #define DMA_K(t,slot) glds16(ksrc+(long)(t)*KVBLK*PITCH,(unsigned)__builtin_amdgcn_readfirstlane(kdst+(slot)))
  #define DMA_V(t,slot) glds16(vsrc+(long)(t)*KVBLK*PITCH,(unsigned)__builtin_amdgcn_readfirstlane(vdst+(slot)))
  const int vb0=(int)(lds0+LDS_V)+((lane>>4)&1)*32+(lane&3)*8+(4*hi+((lane&15)>>2))*64;
  const char*Kbase=shm+LDS_K; bf16x8 kf[8];
  const lds_cptr shm3=(lds_cptr)shm; const lds_cptr kp0=shm3+LDS_K+hi*1024+r32*16; const lds_cptr vp0=shm3+LDS_V+((lane>>4)&1)*32+(lane&3)*8+(4*hi+((lane&15)>>2))*64;
  const int NT=kend-kt0;
  DMA_K(0,0);DMA_V(0,0);DMA_K(1,SLOTB);
  bf16x8 qr[4];
  #pragma unroll
  for(int d0=0;d0<4;++d0)qr[d0]=*reinterpret_cast<const bf16x8*>(&Qw[(long)r32*PITCH+d0*16+hi*8]);
  float mhat=0.f,l_reg=0.f;f32x16 o[2];o[0]=f32x16{};o[1]=f32x16{};f32x16 negm=f32x16{};
  if(MODE==1){ mhat=sink2; l_reg=(hi==0)?1.f:0.f;
    #pragma unroll
    for(int r=0;r<16;++r)negm[r]=-sink2; }
  if(!NOMAX)asm volatile("":"+v"(negm));
  f32x16 lsum=f32x16{}; bf16x8 onesv;
  #pragma unroll
  for(int i_=0;i_<8;++i_)onesv[i_]=(short)0x3F80;
  asm volatile("":"+v"(onesv));
  const int qrel=wid*QBLK+r32;
  const int qk0=q0+qrel-kt0*KVBLK-4*hi;
  #define CMASK(P0,P1,t) do{ if(MODE==1) wmask(P0,P1,(float)(qk0-(t)*KVBLK),slope2); }while(0)
  bool resc=false;
  #define START(P0,P1) do{ resc=false; if(!NOMAX){ const float rm=rowmax(P0,P1); \
    if(MODE==0 || __any(rm>(float)THRL)) { const float dl=(MODE==0)?rm:__builtin_fmaxf(rm,0.f); mhat=fadd_s(mhat,dl); if(MODE==1) l_reg*=__builtin_amdgcn_exp2f(-dl); \
      _Pragma("unroll") for(int r=0;r<16;++r){P0[r]=fsub_s(P0[r],dl);P1[r]=fsub_s(P1[r],dl);} \
      _Pragma("unroll") for(int r=0;r<16;++r)negm[r]=-mhat; asm volatile("":"+v"(negm)); } } \
    _Pragma("unroll") for(int r=0;r<16;++r)P0[r]=__builtin_amdgcn_exp2f(P0[r]); }while(0)
  #define RESC() do{ if(resc){ asm volatile("s_waitcnt lgkmcnt(0)":::"memory"); \
      _Pragma("unroll") for(int d_=0;d_<2;++d_) _Pragma("unroll") for(int r=0;r<16;++r)o[d_][r]*=wsf[crow(r,hi)]; } }while(0)
  f32x16 pA0,pA1,pB0,pB1;
  int sl_prev=0,sl_cur=0,sl_next=SLOTB,sl_n2=2*SLOTB;
  #define ROT() do{sl_prev=sl_cur;sl_cur=sl_next;sl_next=sl_n2;sl_n2=(sl_n2==(NSLOT-1)*SLOTB)?0:sl_n2+SLOTB;}while(0)
  DMA_K(2,2*SLOTB);DMA_K(3,3*SLOTB);DMA_V(1,SLOTB);
  WAIT_BAR(5);
  qkt(pA0,pA1,Kbase,qr,(NOMAX?f32x16{}:negm),r32,hi);asm volatile("s_nop 15\n\ts_nop 7":"+v"(pA0),"+v"(pA1));CMASK(pA0,pA1,0);
  START(pA0,pA1);
  _Pragma("unroll") for(int r=0;r<16;++r)pA1[r]=__builtin_amdgcn_exp2f(pA1[r]);
  WAIT_BAR(2);
  DMA_K(4,4*SLOTB);DMA_V(2,2*SLOTB);
  ROT();
  kload8(kf,kp0+sl_cur);
  s16x4 vlo[8],vhi[8]; u32x4 pw0,pw1,pw2,pw3;
  #define PKW(P,B) cvtpk_s(P[B],P[B+1])
  #define PAF(k) __builtin_bit_cast(bf16x8,pw##k)
  #define VFR(i) (bf16x8){vlo[i][0],vlo[i][1],vlo[i][2],vlo[i][3],vhi[i][0],vhi[i][1],vhi[i][2],vhi[i][3]}
  #define PIN(x) asm volatile("":"+v"(x))
  #define MX3(a,b,c) __builtin_fmaxf(__builtin_fmaxf((a),(b)),(c))
  #define GAPA(MF,A0,A1,A2,A3,W0,W1,PW) do{ MF; if(!NOMAX){ sacc+=A0; sacc+=A1; sacc+=A2; sacc+=A3; PIN(sacc); } W0; W1; PIN(PW); SBAR(); }while(0)
  #define LSUM(k) do{ if(NOMAX){ lsum=__builtin_amdgcn_mfma_f32_32x32x16_bf16(PAF(k),onesv,lsum,0,0,0); SBAR(); } }while(0)
  #define NEGM (NOMAX?f32x16{}:negm)
  #define EX(v) __builtin_amdgcn_exp2f(v)
  #define GAPB(MF,X,B) do{ MF; X[B]=EX(X[B]); X[B+1]=EX(X[B+1]); X[B+2]=EX(X[B+2]); X[B+3]=EX(X[B+3]); PIN(X); SBAR(); }while(0)
  #define VRD(i) do{ vlo[i]=vtr(vp_+(((i)>>2)*4096+((i)&3)*1024)); vhi[i]=vtr(vp_+(((i)>>2)*4096+((i)&3)*1024+512)); }while(0)
  #define KRD(G,j) do{ if(G){ kload2(kf,kp0+sl_next,j); SBAR(); } }while(0)
  #define STEP(C0,C1,P0,P1,t,GK,GV,GL) do{ SBAR(); \
    const lds_cptr vp_=vp0+sl_prev; \
    VRD(0); SBAR(); float sacc=(P0[0]+P0[1]); \
    GAPA(C0=__builtin_amdgcn_mfma_f32_32x32x16_bf16(kf[0],qr[0],NEGM,0,0,0), P0[2],P0[3],P0[4],P0[5],     pw0[0]=PKW(P0,0), pw0[1]=PKW(P0,2), pw0); \
    VRD(4); SBAR(); GAPA(C1=__builtin_amdgcn_mfma_f32_32x32x16_bf16(kf[1],qr[0],NEGM,0,0,0), P0[6],P0[7],P0[8],P0[9],     pw0[2]=PKW(P0,4), pw0[3]=PKW(P0,6), pw0); \
    VRD(1); SBAR(); GAPA(C0=__builtin_amdgcn_mfma_f32_32x32x16_bf16(kf[2],qr[1],C0,0,0,0),   P0[10],P0[11],P0[12],P0[13], pw1[0]=PKW(P0,8), pw1[1]=PKW(P0,10), pw1); \
    VRD(5); SBAR(); GAPA(C1=__builtin_amdgcn_mfma_f32_32x32x16_bf16(kf[3],qr[1],C1,0,0,0),   P0[14],P0[15],P1[0],P1[1],   pw1[2]=PKW(P0,12),pw1[3]=PKW(P0,14), pw1); \
    VRD(2); SBAR(); GAPA(C0=__builtin_amdgcn_mfma_f32_32x32x16_bf16(kf[4],qr[2],C0,0,0,0),   P1[2],P1[3],P1[4],P1[5],     pw2[0]=PKW(P1,0), pw2[1]=PKW(P1,2), pw2); \
    VRD(6); SBAR(); GAPA(C1=__builtin_amdgcn_mfma_f32_32x32x16_bf16(kf[5],qr[2],C1,0,0,0),   P1[6],P1[7],P1[8],P1[9],     pw2[2]=PKW(P1,4), pw2[3]=PKW(P1,6), pw2); \
    VRD(3); SBAR(); GAPA(C0=__builtin_amdgcn_mfma_f32_32x32x16_bf16(kf[6],qr[3],C0,0,0,0),   P1[10],P1[11],P1[12],P1[13], pw3[0]=PKW(P1,8), pw3[1]=PKW(P1,10), pw3); \
    VRD(7); SBAR(); GAPA(C1=__builtin_amdgcn_mfma_f32_32x32x16_bf16(kf[7],qr[3],C1,0,0,0),   P1[14],P1[15],0.f,0.f,       pw3[2]=PKW(P1,12),pw3[3]=PKW(P1,14), pw3); \
    if(!NOMAX)l_reg+=sacc; \
    if(GK){DMA_K((t)+4,sl_prev);} if(GV){DMA_V((t)+2,sl_n2);} \
    CMASK(C0,C1,t); \
    if(!NOMAX){ float a=MX3(C0[0],C0[1],C1[0]),b=MX3(C0[2],C0[3],C1[1]); a=MX3(a,C1[2],C1[3]); \
      _Pragma("unroll") for(int r=4;r<16;r+=4){a=MX3(a,C0[r],C0[r+1]);b=MX3(b,C0[r+2],C0[r+3]);a=MX3(a,C1[r],C1[r+1]);b=MX3(b,C1[r+2],C1[r+3]);} \
      float rm=__builtin_fmaxf(a,b); { auto rr=__builtin_amdgcn_permlane32_swap(__float_as_uint(rm),__float_as_uint(rm),false,false); rm=__builtin_fmaxf(__uint_as_float(rr[0]),__uint_as_float(rr[1])); } \
      resc=false; \
      if(__builtin_expect(__any(rm>(float)THRL),0)){ const float dl=__builtin_fmaxf(rm,0.f); mhat+=dl; \
        _Pragma("unroll") for(int r=0;r<16;++r){C0[r]-=dl;C1[r]-=dl;} \
        _Pragma("unroll") for(int r=0;r<16;++r)negm[r]=-mhat; asm volatile("":"+v"(negm)); \
        const float f=__builtin_amdgcn_exp2f(-dl); l_reg*=f; if(hi==0)wsf[r32]=f; resc=true; } } \
    SBAR(); \
    GAPB(o[0]=__builtin_amdgcn_mfma_f32_32x32x16_bf16(PAF(0),VFR(0),o[0],0,0,0), C0,0); \
    GAPB(o[1]=__builtin_amdgcn_mfma_f32_32x32x16_bf16(PAF(0),VFR(4),o[1],0,0,0), C0,4); LSUM(0); \
    KRD(GL,0); GAPB(o[0]=__builtin_amdgcn_mfma_f32_32x32x16_bf16(PAF(1),VFR(1),o[0],0,0,0), C0,8); \
    KRD(GL,1); GAPB(o[1]=__builtin_amdgcn_mfma_f32_32x32x16_bf16(PAF(1),VFR(5),o[1],0,0,0), C0,12); LSUM(1); \
    KRD(GL,2); GAPB(o[0]=__builtin_amdgcn_mfma_f32_32x32x16_bf16(PAF(2),VFR(2),o[0],0,0,0), C1,0); \
    KRD(GL,3); GAPB(o[1]=__builtin_amdgcn_mfma_f32_32x32x16_bf16(PAF(2),VFR(6),o[1],0,0,0), C1,4); LSUM(2); \
    GAPB(o[0]=__builtin_amdgcn_mfma_f32_32x32x16_bf16(PAF(3),VFR(3),o[0],0,0,0), C1,8); \
    GAPB(o[1]=__builtin_amdgcn_mfma_f32_32x32x16_bf16(PAF(3),VFR(7),o[1],0,0,0), C1,12); LSUM(3); \
    }while(0)
  int t=1;
  for(;t+5<NT;t+=2){
    STEP(pB0,pB1,pA0,pA1,t,true,true,true);     WAIT_BAR(2); RESC(); ROT();
    STEP(pA0,pA1,pB0,pB1,t+1,true,true,true);   RESC(); ROT();
  }
  #define ENDW(tt) do{ if((tt)+4<NT){WAIT_BAR(2);} else if((tt)+2<NT){WAIT_BAR(1);} else {WAIT_BAR(0);} }while(0)
  for(;t+1<NT;t+=2){
    STEP(pB0,pB1,pA0,pA1,t,(t+4<NT),(t+2<NT),(t+1<NT));       ENDW(t);   RESC(); ROT();
    STEP(pA0,pA1,pB0,pB1,t+1,(t+5<NT),(t+3<NT),(t+2<NT));     if(t+3>=NT){WAIT_BAR(0);} RESC(); ROT();
  }
  STEP(pB0,pB1,pA0,pA1,NT-1,false,false,false); RESC();
  { float sacc=pB0[0]+pB0[1]; _Pragma("unroll") for(int r=2;r<16;++r)sacc+=pB0[r]; _Pragma("unroll") for(int r=0;r<16;++r)sacc+=pB1[r]; l_reg+=sacc;
    pw0=(u32x4){PKW(pB0,0),PKW(pB0,2),PKW(pB0,4),PKW(pB0,6)};pw1=(u32x4){PKW(pB0,8),PKW(pB0,10),PKW(pB0,12),PKW(pB0,14)};pw2=(u32x4){PKW(pB1,0),PKW(pB1,2),PKW(pB1,4),PKW(pB1,6)};pw3=(u32x4){PKW(pB1,8),PKW(pB1,10),PKW(pB1,12),PKW(pB1,14)};
    SBAR(); pv(o,vb0+sl_cur,PAF(0),PAF(1),PAF(2),PAF(3)); LSUM(0); LSUM(1); LSUM(2); LSUM(3); }
  #undef PKW
  #undef PAF
  #undef VFR
  #undef PIN
  #undef MX3
  #undef GAPA
  #undef LSUM
  #undef GAPB
  #undef EX
  #undef VRD
  #undef KRD
  #undef STEP
  #undef ENDW
  {auto rr=__builtin_amdgcn_permlane32_swap(__float_as_uint(l_reg),__float_as_uint(l_reg),false,false);l_reg=__uint_as_float(rr[0])+__uint_as_float(rr[1]);}
  if(hi==0)wsf[32+r32]=l_reg;asm volatile("s_waitcnt lgkmcnt(0)":::"memory");
  float rli[16];
  #pragma unroll
  for(int r=0;r<16;++r)rli[r]=NOMAX?__builtin_amdgcn_rcpf(lsum[r]):__builtin_amdgcn_rcpf(wsf[32+crow(r,hi)]);
  #undef NEGM
  bf16*Ow=Os+(long)(q0+wid*QBLK)*OPITCH;
  { bf16*stg=(bf16*)(shm+LDS_OST)+wid*2048;
    #pragma unroll
    for(int r=0;r<16;++r){const int orow=crow(r,hi);
      #pragma unroll
      for(int d0=0;d0<2;++d0)stg[orow*64+d0*32+r32]=__float2bfloat16(o[d0][r]*rli[r]);}
    asm volatile("s_waitcnt lgkmcnt(0)":::"memory");
    #pragma unroll
    for(int i=0;i<4;++i){const int row=i*8+(lane>>3),ch=lane&7; const u32x4 v=*(const u32x4*)(stg+row*64+ch*8); ATTN_STORE16(Ow+(long)row*OPITCH+ch*8,v);
      float sq=0.f;
      #pragma unroll
      for(int k=0;k<4;++k){const float a=__uint_as_float(v[k]<<16),b=__uint_as_float(v[k]&0xffff0000u); sq+=a*a+b*b;}
      sq+=__shfl_xor(sq,1); sq+=__shfl_xor(sq,2); sq+=__shfl_xor(sq,4);
      if(ch==0)ssq[(long)(q0+wid*QBLK+row)*16]=sq;} }
  asm volatile("s_waitcnt lgkmcnt(0)\n\ts_barrier":::"memory");
  #undef DMA_K
  #undef DMA_V
  #undef CMASK
  #undef START
  #undef RESC
  #undef ROT
}
constexpr int ATTN_LDS_BYTES=LDS_BYTES;
#undef SBAR
#undef WAIT_BAR
}
#include <hip/hip_cooperative_groups.h>
namespace cg = cooperative_groups;
constexpr int NWAVES = 8;
#ifndef PHASES
#define PHASES 0xffff
#endif
#define PH(n) if constexpr ((PHASES >> (n)) & 1)
#ifndef REP_SYNC
#define REP_SYNC 1
#endif
#ifndef REP_PRO
#define REP_PRO 1
#endif
#ifndef REP_EPOST
#define REP_EPOST 1
#endif
#ifndef REP_ONORM
#define REP_ONORM 1
#endif
#if REP_SYNC == 2
#define GSYNC() do { xcd_barrier(xbar, MYTID() == 0); xcd_barrier(xbar, MYTID() == 0); } while (0)
#else
#define GSYNC() xcd_barrier(xbar, MYTID() == 0)
#endif
#ifndef GEMM_SP2
#define GEMM_SP2 true
#endif
#ifndef HALF_TAIL_GU
#define HALF_TAIL_GU false
#endif
#ifndef SWIGLU_ALIGN
#define SWIGLU_ALIGN true
#endif
#ifndef REP_GU
#define REP_GU REP_GEMM
#endif
#ifndef REP_DN
#define REP_DN REP_GEMM
#endif
#ifndef REP_ATTN
#define REP_ATTN 1
#endif
#ifndef REP_GEMM
#define REP_GEMM 1
#endif
constexpr int DM = 1024, DFF = 2816, NIN = 1536, DEPTH = 2;
constexpr int M_P = 32768, M_S = 16384, M = M_P + M_S;
constexpr int S_P = 16384, S_S = 8192;
constexpr float EPS = 1e-6f;
constexpr float LOG2E = 1.4426950408889634f;
constexpr size_t MiB = 1u << 20;
constexpr int RING_BYTES = 131072, LDS_BYTES = 147456;
constexpr size_t W_LAYER = 38 * MiB, W_GU1 = 0, W_D1 = 11 * MiB, W_IN = 16 * MiB + MiB / 2, W_OUT = 19 * MiB + MiB / 2, W_GU2 = 21 * MiB + MiB / 2, W_D2 = 32 * MiB + MiB / 2;
constexpr size_t WS_ACT = 76 * MiB, WS_BIG = 172 * MiB, WS_O = WS_BIG + 144 * MiB, WS_RSX = 436 * MiB, WS_SSQ = 437 * MiB, WS_END = 441 * MiB;
constexpr int YLD = 2048;
constexpr size_t WS_CTL = WS_RSX + 512 * 1024, CTL_BYTES = 16384;
constexpr int MISC_OFF = RING_BYTES + 320;
static_assert(W_D2 + (size_t)DM * DFF * 2 == W_LAYER && WS_ACT + (size_t)M * DM * 2 == WS_BIG && WS_BIG + (size_t)M * DFF * 2 == WS_RSX && WS_O + (size_t)M * DM * 2 <= WS_END, "ws map");
#define LAS __attribute__((address_space(3)))
typedef unsigned short bfu;
typedef unsigned v4u __attribute__((ext_vector_type(4)));
typedef unsigned v2u __attribute__((ext_vector_type(2)));
typedef float f32x4 __attribute__((ext_vector_type(4)));
#define LDS_WAIT() asm volatile("s_waitcnt lgkmcnt(0)" ::: "memory")
__device__ __forceinline__ unsigned pk2(float lo, float hi) { return pg8::cvt_pk_bf16(lo, hi); }
__device__ __forceinline__ float bflo(unsigned w) { return __uint_as_float(w << 16); }
__device__ __forceinline__ float bfhi(unsigned w) { return __uint_as_float(w & 0xffff0000u); }
__device__ __forceinline__ float wave_sum(float v) {
#pragma unroll
    for (int o = 1; o < 64; o <<= 1) v += __shfl_xor(v, o);
    return v;
}
__device__ __forceinline__ int lsg(int x) { asm volatile("" : "+s"(x)); return x; }
__device__ __forceinline__ float dot4(f32x4 a) { return (a.x * a.x + a.y * a.y) + (a.z * a.z + a.w * a.w); }

__device__ __forceinline__ void transpose_item(const float* W, int K, int N, bfu* WT, const float* g, const float* g2, int mode, LAS float* scr, int item, int lane) {
    const int nblk = N / 32, kb = item / nblk, nb = item % nblk, k0 = 64 * kb, n0 = 32 * nb;
    const float* gp = g ? ((g2 && k0 >= 512) ? g2 + (k0 - 512) : g + k0) : nullptr;
#pragma unroll
    for (int i = 0; i < 32; ++i) { const int kk = 2 * i + (lane >> 5); const float gv = gp ? gp[kk] : 1.0f; scr[kk * 33 + (lane & 31)] = W[(size_t)(k0 + kk) * N + n0 + (lane & 31)] * gv; }
    LDS_WAIT(); asm volatile("" ::: "memory");
    const int c = lane & 7;
    const int r0 = (mode == 0) ? n0 : (mode == 3) ? ((n0 & ~255) + 128 * ((n0 >> 5) & 1) + 32 * ((n0 >> 6) & 3)) : (256 * (n0 >> 7) + (n0 & 127) + (mode == 2 ? 128 : 0));
#pragma unroll
    for (int j = 0; j < 4; ++j) { const int n = (lane >> 3) + 8 * j; const LAS float* s = scr + (8 * c) * 33 + n;
        v4u o; o.x = pk2(s[0 * 33], s[1 * 33]); o.y = pk2(s[2 * 33], s[3 * 33]); o.z = pk2(s[4 * 33], s[5 * 33]); o.w = pk2(s[6 * 33], s[7 * 33]);
        *(v4u*)(WT + (size_t)(r0 + n) * K + k0 + 8 * c) = o; }
    LDS_WAIT(); asm volatile("" ::: "memory");
}
struct TiDesc { const float* W; bfu* WT; const float* g; const float* g2; int K, N, mode, item; };
__device__ __forceinline__ void ti_load(const TiDesc& d, int lane, f32x4 (&v)[8], f32x4 (&gv)[2], size_t& dst) {
    const int nblk = d.N / 32, kb = d.item / nblk, nb = d.item % nblk, k0 = 64 * kb, n0 = 32 * nb, ng = lane & 7, kg = lane >> 3;
    const float* src = d.W + (size_t)(k0 + 8 * kg) * d.N + n0 + 4 * ng;
#pragma unroll
    for (int i = 0; i < 8; ++i) v[i] = *(const f32x4*)(src + (size_t)i * d.N);
    if (d.g) { const float* gp = ((d.g2 && k0 >= 512) ? d.g2 + (k0 - 512) : d.g + k0) + 8 * kg; gv[0] = *(const f32x4*)gp; gv[1] = *(const f32x4*)(gp + 4); }
    else { gv[0] = (f32x4){1.f, 1.f, 1.f, 1.f}; gv[1] = gv[0]; }
    const int r0 = (d.mode == 0) ? n0 : (d.mode == 3) ? ((n0 & ~255) + 128 * ((n0 >> 5) & 1) + 32 * ((n0 >> 6) & 3)) : (256 * (n0 >> 7) + (n0 & 127) + (d.mode == 2 ? 128 : 0));
    dst = (size_t)(r0 + 4 * ng) * d.K + k0 + 8 * kg;
}
__device__ __forceinline__ void ti_store(const TiDesc& d, const f32x4 (&v)[8], const f32x4 (&gv)[2], size_t dst) {
#pragma unroll
    for (int j = 0; j < 4; ++j) { v4u o; o.x = pk2(v[0][j] * gv[0][0], v[1][j] * gv[0][1]); o.y = pk2(v[2][j] * gv[0][2], v[3][j] * gv[0][3]); o.z = pk2(v[4][j] * gv[1][0], v[5][j] * gv[1][1]); o.w = pk2(v[6][j] * gv[1][2], v[7][j] * gv[1][3]);
        *(v4u*)(d.WT + dst + (size_t)j * d.K) = o; }
}
__device__ __forceinline__ void unpack8(const v4u w, float (&x)[8]) { x[0] = bflo(w.x); x[1] = bfhi(w.x); x[2] = bflo(w.y); x[3] = bfhi(w.y); x[4] = bflo(w.z); x[5] = bfhi(w.z); x[6] = bflo(w.w); x[7] = bfhi(w.w); }
__device__ __forceinline__ v4u pack8(const float (&x)[8]) { v4u r; r.x = pk2(x[0], x[1]); r.y = pk2(x[2], x[3]); r.z = pk2(x[4], x[5]); r.w = pk2(x[6], x[7]); return r; }
template <int R> __device__ __forceinline__ void wave_sum_n(float (&v)[R]) {
#pragma unroll
    for (int o = 1; o < 64; o <<= 1) {
#pragma unroll
        for (int r = 0; r < R; ++r) v[r] += __shfl_xor(v[r], o); }
}
__device__ __forceinline__ void e_first_rows4(const float* x0, bfu* xb0, float* rsx, int lane) {
    f32x4 v[4][2][2];
#pragma unroll
    for (int r = 0; r < 4; ++r)
#pragma unroll
        for (int h = 0; h < 2; ++h) { const f32x4* p = (const f32x4*)(x0 + (size_t)r * DM + 512 * h + 8 * lane); v[r][h][0] = p[0]; v[r][h][1] = p[1]; }
    float ss[4];
#pragma unroll
    for (int r = 0; r < 4; ++r) { ss[r] = (dot4(v[r][0][0]) + dot4(v[r][0][1])) + (dot4(v[r][1][0]) + dot4(v[r][1][1]));
#pragma unroll
        for (int h = 0; h < 2; ++h) { v4u w; w.x = pk2(v[r][h][0].x, v[r][h][0].y); w.y = pk2(v[r][h][0].z, v[r][h][0].w); w.z = pk2(v[r][h][1].x, v[r][h][1].y); w.w = pk2(v[r][h][1].z, v[r][h][1].w);
            *(v4u*)(xb0 + (size_t)r * DM + 512 * h + 8 * lane) = w; } }
    wave_sum_n<4>(ss);
    if (lane < 4) { const float sv = lane == 0 ? ss[0] : lane == 1 ? ss[1] : lane == 2 ? ss[2] : ss[3]; rsx[lane] = __builtin_amdgcn_rsqf(sv * (1.f / DM) + EPS); }
}
template <bool FINAL, int R> __device__ __forceinline__ void e_post_rows(const bfu* y0, bfu* xb0, float* rsx, float* out0, const float* gpost, float scale, int lane) {
    v4u yw[R][2], xw[R][2];
#pragma unroll
    for (int r = 0; r < R; ++r)
#pragma unroll
        for (int h = 0; h < 2; ++h) { yw[r][h] = *(const v4u*)(y0 + (size_t)r * YLD + 512 * h + 8 * lane); xw[r][h] = *(const v4u*)(xb0 + (size_t)r * DM + 512 * h + 8 * lane); }
    asm volatile("" ::: "memory");
    f32x4 g[2][2];
#pragma unroll
    for (int h = 0; h < 2; ++h) { const f32x4* p = (const f32x4*)(gpost + 512 * h + 8 * lane); g[h][0] = p[0]; g[h][1] = p[1]; }
    float sy[R];
#pragma unroll
    for (int r = 0; r < R; ++r) { float a = 0.f;
#pragma unroll
        for (int h = 0; h < 2; ++h) { float y[8]; unpack8(yw[r][h], y);
#pragma unroll
            for (int k = 0; k < 8; ++k) a += y[k] * y[k]; }
        sy[r] = a; }
    wave_sum_n<R>(sy);
    float sx[R];
#pragma unroll
    for (int r = 0; r < R; ++r) { const float rs = __builtin_amdgcn_rsqf(sy[r] * (1.f / DM) + EPS) * scale; float a = 0.f;
#pragma unroll
        for (int h = 0; h < 2; ++h) { float y[8], x[8]; unpack8(yw[r][h], y); unpack8(xw[r][h], x);
            const float gg[8] = {g[h][0].x, g[h][0].y, g[h][0].z, g[h][0].w, g[h][1].x, g[h][1].y, g[h][1].z, g[h][1].w};
#pragma unroll
            for (int k = 0; k < 8; ++k) { x[k] = x[k] + y[k] * rs * gg[k]; a += x[k] * x[k]; }
            if (FINAL) { f32x4* po = (f32x4*)(out0 + (size_t)r * DM + 512 * h + 8 * lane); po[0] = (f32x4){x[0], x[1], x[2], x[3]}; po[1] = (f32x4){x[4], x[5], x[6], x[7]}; }
            else *(v4u*)(xb0 + (size_t)r * DM + 512 * h + 8 * lane) = pack8(x); }
        sx[r] = a; }
    if (!FINAL) { wave_sum_n<R>(sx);
        float sv = sx[0];
#pragma unroll
        for (int r = 1; r < R; ++r) sv = (lane == r) ? sx[r] : sv;
        if (lane < R) rsx[lane] = __builtin_amdgcn_rsqf(sv * (1.f / DM) + EPS); }
}
__device__ __forceinline__ void e_onorm_rows4(bfu* o0, int lane) {
    v4u w[4][2];
#pragma unroll
    for (int r = 0; r < 4; ++r)
#pragma unroll
        for (int h = 0; h < 2; ++h) w[r][h] = *(const v4u*)(o0 + (size_t)r * DM + 512 * h + 8 * lane);
    float ss[8];
#pragma unroll
    for (int r = 0; r < 4; ++r)
#pragma unroll
        for (int h = 0; h < 2; ++h) { float x[8]; unpack8(w[r][h], x); float a = 0.f;
#pragma unroll
            for (int k = 0; k < 8; ++k) a += x[k] * x[k];
            ss[2 * r + h] = a; }
    wave_sum_n<8>(ss);
#pragma unroll
    for (int r = 0; r < 4; ++r)
#pragma unroll
        for (int h = 0; h < 2; ++h) { float x[8]; unpack8(w[r][h], x); const float rstd = __builtin_amdgcn_rsqf(ss[2 * r + h] * (1.f / 512.f) + EPS);
#pragma unroll
            for (int k = 0; k < 8; ++k) x[k] *= rstd;
            *(v4u*)(o0 + (size_t)r * DM + 512 * h + 8 * lane) = pack8(x); }
}
#define XB_TMO      128
#define XB_XCNT(j)  (256  + 64 * (j))
#define XB_XSUB(j)  (1280 + 64 * (j))
#define XB_XGEN(j)  (2304 + 64 * (j))
#define XB_TOP      3328
#define XB_TOPGEN   3392
#define XCD_BAR_WORDS 3456
#define XB_SPIN_CAP (1u << 18)

__device__ __forceinline__ unsigned xb_ld(unsigned* p)              { return __hip_atomic_load(p, __ATOMIC_RELAXED, __HIP_MEMORY_SCOPE_AGENT); }
__device__ __forceinline__ unsigned xb_add(unsigned* p, unsigned v) { return __hip_atomic_fetch_add(p, v, __ATOMIC_RELAXED, __HIP_MEMORY_SCOPE_AGENT); }
__device__ __forceinline__ unsigned xb_xcc_id() { return (unsigned)__builtin_amdgcn_s_getreg((3 << 11) | 20) & 0xFu; }
#define XB_SPIN(cond, bar) do { unsigned _sp = 0; while (cond) { __builtin_amdgcn_s_sleep(1); \
    if ((++_sp & 255u) == 0u) { if (xb_ld(&(bar)[XB_TMO])) break; if (_sp > XB_SPIN_CAP) { atomicAdd(&(bar)[XB_TMO], 1u); break; } } } } while (0)

struct XcdBarrier {
    unsigned* bar; unsigned x;
    volatile LAS unsigned* st;
};

__device__ __forceinline__ XcdBarrier xcd_barrier_post(unsigned* bar, volatile LAS unsigned* st, bool t0) {
    XcdBarrier b; b.bar = bar; b.x = xb_xcc_id(); b.st = st;
    if (t0) (void)xb_add(&bar[XB_XCNT(b.x)], 1u);
    return b;
}
__device__ __forceinline__ void xcd_barrier_complete(unsigned* bar, unsigned x, unsigned& nloc, unsigned& nx) {
    const unsigned G = gridDim.x * gridDim.y * gridDim.z;
    unsigned sum, cnt, mine, sp = 0u;
    for (;;) {
        sum = 0u; cnt = 0u; mine = 0u;
#pragma unroll
        for (unsigned j = 0; j < 16; ++j) { const unsigned c = xb_ld(&bar[XB_XCNT(j)]); sum += c; cnt += (c > 0u) ? 1u : 0u; mine = (j == x) ? c : mine; }
        if (sum == G) break;
        __builtin_amdgcn_s_sleep(1);
        if ((++sp & 255u) == 0u) { if (xb_ld(&bar[XB_TMO])) break; if (sp > XB_SPIN_CAP) { atomicAdd(&bar[XB_TMO], 1u); break; } }
    }
    nloc = mine > 0u ? mine : 1u; nx = cnt > 0u ? cnt : 1u;
}

__device__ __forceinline__ void xcd_barrier(const XcdBarrier& b, bool t0) {
    asm volatile("s_waitcnt vmcnt(0)" ::: "memory");
    __syncthreads();
    if (t0) {
        unsigned* bar = b.bar;
        __builtin_amdgcn_s_waitcnt(0);
        unsigned nloc = b.st[0], nx = b.st[1];
        if (nloc == 0u) { xcd_barrier_complete(bar, b.x, nloc, nx); b.st[0] = nloc; b.st[1] = nx; }
        const unsigned old = xb_add(&bar[XB_XSUB(b.x)], 1u);
        const unsigned gen = old / nloc;
        if (old + 1u == (gen + 1u) * nloc) {
            __builtin_amdgcn_fence(__ATOMIC_RELEASE, "agent");
            asm volatile("s_waitcnt vmcnt(0)" ::: "memory");
            const unsigned og = xb_add(&bar[XB_TOP], 1u);
            const unsigned tg = og / nx;
            if (og + 1u == (tg + 1u) * nx) xb_add(&bar[XB_TOPGEN], 1u);
            else XB_SPIN(xb_ld(&bar[XB_TOPGEN]) == tg, bar);
            __builtin_amdgcn_fence(__ATOMIC_ACQUIRE, "agent");
            xb_add(&bar[XB_XGEN(b.x)], 1u);
            asm volatile("s_waitcnt vmcnt(0)" ::: "memory");
        } else {
            XB_SPIN(xb_ld(&bar[XB_XGEN(b.x)]) == gen, bar);
            __builtin_amdgcn_fence(__ATOMIC_ACQUIRE, "agent");
            asm volatile("s_waitcnt vmcnt(0)" ::: "memory");
        }
    }
    __syncthreads();
}

__device__ __forceinline__ void attn_phase(char* lds, const attn_body::bf16* P, attn_body::bf16* O, const float* sink, float* ssq, const float* gq, const float* gk, int vcu, int G, int tid_in) {
    bool nomax;
    { int ln_ = tid_in & 63; float a = __builtin_fabsf(gq[ln_]), b = __builtin_fabsf(gk[ln_]);
#pragma unroll
      for (int o = 1; o < 64; o <<= 1) { a = __builtin_fmaxf(a, __shfl_xor(a, o)); b = __builtin_fmaxf(b, __shfl_xor(b, o)); }
      const float B2 = 64.f * a * b * attn_body::C2; nomax = __builtin_amdgcn_readfirstlane((int)(B2 < 96.f)) != 0; }
    for (int L = vcu; L < 3072; L += G) {
        int mode, S, rowbase, q0, hq;
        if (L < 1536) {
            mode = 0; int b, hkv, g, qb;
            if (L < 1024) { const int i = L >> 8, v = L & 255, x = v >> 5, c = v & 31, u = 128 * (x & 1) + i * 32 + c, combo = x >> 1; b = combo >> 1; hkv = combo & 1; g = u >> 6; qb = u & 63; S = S_P; rowbase = b * S_P; }
            else { const int Ls = L - 1024, i = Ls >> 8, v = Ls & 255, x = v >> 5, c = v & 31, u = 64 * (x & 1) + i * 32 + c, combo = x >> 1; b = combo >> 1; hkv = combo & 1; g = u >> 5; qb = u & 31; S = S_S; rowbase = M_P + b * S_S; }
            hq = hkv * 4 + g; q0 = qb * 256;
        } else {
            mode = 1; const int Lw = L - 1536; hq = Lw & 7; const int row0 = (Lw >> 3) * 256;
            if (row0 < M_P) { S = S_P; rowbase = row0 & ~(S_P - 1); } else { S = S_S; rowbase = M_P + ((row0 - M_P) & ~(S_S - 1)); }
            q0 = row0 - rowbase;
        }
        const attn_body::bf16* Q = P + (size_t)rowbase * NIN + mode * 768 + hq * 64;
        const attn_body::bf16* K = P + (size_t)rowbase * NIN + mode * 768 + 512 + (hq >> 2) * 64;
        const attn_body::bf16* V = K + 128;
        attn_body::bf16* Oo = O + (size_t)rowbase * DM + mode * 512 + hq * 64; float* sq = ssq + (size_t)rowbase * 16 + mode * 8 + hq;
        if (mode == 0) { if (nomax) attn_body::attn_unit<0, 8, true>(Q, K, V, Oo, S, q0, 0.f, 0.f, sq, lds, tid_in); else attn_body::attn_unit<0, 8, false>(Q, K, V, Oo, S, q0, 0.f, 0.f, sq, lds, tid_in); }
        else { const float sink2 = sink[hq] * LOG2E; const float slope2 = __builtin_amdgcn_exp2f(-(float)(hq + 1)) * LOG2E; attn_body::attn_unit<1, 8, false>(Q, K, V, Oo, S, q0, sink2, slope2, sq, lds, tid_in); }
    }
}

struct Args { const float* in[21]; float* out; unsigned char* ws; };
__global__ void __launch_bounds__(NWAVES * 64, 2) mega_fwd(Args args) {
    extern __shared__ __attribute__((aligned(16))) unsigned char lds[];
    cg::grid_group grid = cg::this_grid();
    const int wave = __builtin_amdgcn_readfirstlane((int)threadIdx.x >> 6);
#define lane ({ int l_ = (int)__builtin_amdgcn_mbcnt_hi(~0u, __builtin_amdgcn_mbcnt_lo(~0u, 0u)); asm volatile("" : "+v"(l_)); l_; })
#define MYTID() ((wave << 6) | lane)
    const int G = gridDim.x; const int bx = blockIdx.x; const int vcu = (G % 8 == 0) ? (bx % 8) * (G / 8) + bx / 8 : bx;
    const int gw = vcu * NWAVES + wave, NGW = G * NWAVES;
    typedef const __attribute__((address_space(4))) Args* kargp_t;
    kargp_t kap = (kargp_t)__builtin_amdgcn_kernarg_segment_ptr();
#define KARG() ({ kargp_t p_ = kap; asm volatile("" : "+s"(p_)); p_; })
#define INP(i) (KARG()->in[i])
#define ws (KARG()->ws)
#define xout (KARG()->out)
#define XB ((bfu*)(ws + WS_ACT))
#define HB ((bfu*)(ws + WS_BIG))
#define PB ((bfu*)(ws + WS_BIG))
#define OB ((bfu*)(ws + WS_O))
#define RSX ((float*)(ws + WS_RSX))
#define SSQ ((float*)(ws + WS_SSQ))
#define YB ((bfu*)xout)
    LAS unsigned char* ldsp = (LAS unsigned char*)lds;
    if (MYTID() < 32) ((LAS unsigned*)(ldsp + MISC_OFF))[MYTID()] = 0u;
    __syncthreads();
    XcdBarrier xbar = xcd_barrier_post((unsigned*)(ws + WS_CTL), (volatile LAS unsigned*)(ldsp + MISC_OFF) + 8, MYTID() == 0);

    constexpr int I_G = (DM / 64) * (DFF / 32), I_D = (DFF / 64) * (DM / 32), I_I = (DM / 64) * (NIN / 32), I_O = (DM / 64) * (DM / 32);
    constexpr int PER_LAYER = 4 * I_G + 2 * I_D + I_I + I_O;
#define TI_DECODE(d, it_) do { const int l_ = (it_) / PER_LAYER; int r = (it_) % PER_LAYER; unsigned char* wl_ = ws + (size_t)l_ * W_LAYER; \
            if (r < I_G) { d = TiDesc{INP(4) + (size_t)l_ * DM * DFF, (bfu*)(wl_ + W_GU1), INP(2) + l_ * DM, nullptr, DM, DFF, 1, r}; break; } r -= I_G; \
            if (r < I_G) { d = TiDesc{INP(5) + (size_t)l_ * DM * DFF, (bfu*)(wl_ + W_GU1), INP(2) + l_ * DM, nullptr, DM, DFF, 2, r}; break; } r -= I_G; \
            if (r < I_D) { d = TiDesc{INP(6) + (size_t)l_ * DM * DFF, (bfu*)(wl_ + W_D1), nullptr, nullptr, DFF, DM, 0, r}; break; } r -= I_D; \
            if (r < I_I) { d = TiDesc{INP(9) + (size_t)l_ * DM * NIN, (bfu*)(wl_ + W_IN), INP(7) + l_ * DM, nullptr, DM, NIN, 3, r}; break; } r -= I_I; \
            if (r < I_O) { d = TiDesc{INP(15) + (size_t)l_ * DM * DM, (bfu*)(wl_ + W_OUT), INP(13) + l_ * 512, INP(14) + l_ * 512, DM, DM, 0, r}; break; } r -= I_O; \
            if (r < I_G) { d = TiDesc{INP(18) + (size_t)l_ * DM * DFF, (bfu*)(wl_ + W_GU2), INP(16) + l_ * DM, nullptr, DM, DFF, 1, r}; break; } r -= I_G; \
            if (r < I_G) { d = TiDesc{INP(19) + (size_t)l_ * DM * DFF, (bfu*)(wl_ + W_GU2), INP(16) + l_ * DM, nullptr, DM, DFF, 2, r}; break; } r -= I_G; \
            d = TiDesc{INP(20) + (size_t)l_ * DM * DFF, (bfu*)(wl_ + W_D2), nullptr, nullptr, DFF, DM, 0, r}; } while (0)
#define CONV_RANGE(LO, HI, W0, NW) do { const int ln_ = lane; const int nw_ = (NW); for (int it = (LO) + (W0); it < (HI); it += 2 * nw_) { \
            TiDesc da, db; f32x4 va[8], vb[8], ga[2], gb[2]; size_t dsta, dstb = 0; const bool two = (it + nw_) < (HI); \
            TI_DECODE(da, it); ti_load(da, ln_, va, ga, dsta); \
            if (two) { TI_DECODE(db, it + nw_); ti_load(db, ln_, vb, gb, dstb); } \
            ti_store(da, va, ga, dsta); \
            if (two) ti_store(db, vb, gb, dstb); } } while (0)
#ifndef TAIL_CONV
#define TAIL_CONV 0
#endif
#define CONV_TAIL(LO, HI, NWG) do { const int G_ = lsg(G), rem_ = (NWG) % G_, bx_ = lsg(bx); const int lo_ = lsg(LO), hi_ = lsg(HI); \
            int w0_ = lsg(gw), nw_t = lsg(NGW); if (rem_ != 0) { w0_ = (bx_ - rem_) * NWAVES + wave; nw_t = (G_ - rem_) * NWAVES; } \
            if (rem_ == 0 || bx_ >= rem_) { asm volatile("" ::: "memory"); CONV_RANGE(lo_, hi_, lsg(w0_), lsg(nw_t)); asm volatile("" ::: "memory"); } } while (0)
    PH(0) for (int rp = 0; rp < REP_PRO; ++rp) {
        CONV_RANGE(0, TAIL_CONV ? 2 * I_G : DEPTH * PER_LAYER, lsg(gw), lsg(NGW));
        for (int m = 4 * lsg(gw); m < M; m += 4 * lsg(NGW)) { const float* xr = (m < M_P) ? INP(0) + (size_t)m * DM : INP(1) + (size_t)(m - M_P) * DM; e_first_rows4(xr, XB + (size_t)m * DM, RSX + m, lane); }
    }
    grid.sync();

#define GEMM_SWIGLU(WOFF) do { pg8::Gemm g{XB, (const bfu*)(wl + (WOFF)), M, 2 * DFF, DM}; pg8::StaticOrder S; S.init(M, 2 * DFF, lsg(G), lsg(bx), HALF_TAIL_GU); pg8::EpiSwiGLU E{HB, DFF, RSX}; \
        pg8::gemm_phase<pg8::EpiSwiGLU, pg8::StaticOrder, SWIGLU_ALIGN, GEMM_SP2>(ldsp, g, S, E, MYTID()); } while (0)
#ifndef DOWN_REV
#define DOWN_REV true
#endif
#define GEMM_PLAIN(A_, WOFF, N_, K_, O_, LDC) do { pg8::Gemm g{(A_), (const bfu*)(wl + (WOFF)), M, (N_), (K_)}; pg8::StaticOrder S; S.init(M, (N_), lsg(G), lsg(bx), false, DOWN_REV); pg8::EpiPlain E{(O_), (LDC), 0, 0, 1.0f}; \
        pg8::gemm_phase<pg8::EpiPlain, pg8::StaticOrder, true, GEMM_SP2>(ldsp, g, S, E, MYTID()); } while (0)
#define GEMM_WIN() do { pg8::Gemm g{XB, (const bfu*)(wl + W_IN), M, NIN, DM}; pg8::StaticOrder S; S.init(M, NIN, lsg(G), lsg(bx)); pg8::EpiWin E{PB, RSX, INP(10) + l * 64, INP(11) + l * 64, attn_body::C2}; \
        pg8::gemm_phase<pg8::EpiWin, pg8::StaticOrder, true, GEMM_SP2>(ldsp, g, S, E, MYTID()); } while (0)
#define GEMM_WOUT() do { pg8::Gemm g{OB, (const bfu*)(wl + W_OUT), M, DM, DM}; pg8::StaticOrder S; S.init(M, DM, lsg(G), lsg(bx)); pg8::EpiOutNorm E{YB, YLD, SSQ}; \
        pg8::gemm_phase<pg8::EpiOutNorm, pg8::StaticOrder, true, GEMM_SP2>(ldsp, g, S, E, MYTID()); } while (0)
#ifndef EP_ROWS
#define EP_ROWS 4
#endif
#define E_POST(GP, SCALE, FINAL) do { for (int rp = 0; rp < ((FINAL) ? 1 : REP_EPOST); ++rp) for (int m = EP_ROWS * lsg(gw); m < M; m += EP_ROWS * lsg(NGW)) \
        e_post_rows<FINAL, EP_ROWS>(YB + (size_t)m * YLD, XB + (size_t)m * DM, RSX + m, xout + (size_t)m * DM, (GP), rp == 0 ? (SCALE) : 0.0f, lane); } while (0)

#pragma nounroll
    for (int l = 0; l < DEPTH; ++l) {
#define wl (ws + (size_t)l * W_LAYER)
        PH(1) for (int rp = 0; rp < REP_GU; ++rp) GEMM_SWIGLU(W_GU1);
        if (TAIL_CONV && l == 0) CONV_TAIL(2 * I_G, PER_LAYER, (M / 256) * (2 * DFF / 256));
        GSYNC();
        PH(2) { GEMM_PLAIN(HB, W_D1, DM, DFF, YB, YLD); if (REP_DN == 2) GEMM_PLAIN(HB, W_D1, DM, DFF, YB, YLD); }
        GSYNC();
        PH(3) E_POST(INP(3) + l * DM, 0.5f, false);
        GSYNC();
        PH(4) for (int rp = 0; rp < REP_GEMM; ++rp) GEMM_WIN();
        if (TAIL_CONV && l + 1 < DEPTH) CONV_TAIL((l + 1) * PER_LAYER, (l + 1) * PER_LAYER + 2 * I_G, (M / 256) * (NIN / 256));
        GSYNC();
        PH(6) for (int rp = 0; rp < REP_ATTN; ++rp) attn_phase((char*)lds, (const attn_body::bf16*)PB, (attn_body::bf16*)OB, INP(12) + l * 8, SSQ, INP(10) + l * 64, INP(11) + l * 64, lsg(vcu), lsg(G), MYTID());
        GSYNC();
        PH(8) for (int rp = 0; rp < REP_GEMM; ++rp) GEMM_WOUT();
        GSYNC();
        PH(9) E_POST(INP(8) + l * DM, 1.0f, false);
        GSYNC();
        PH(10) for (int rp = 0; rp < REP_GU; ++rp) GEMM_SWIGLU(W_GU2);
        if (TAIL_CONV && l + 1 < DEPTH) CONV_TAIL((l + 1) * PER_LAYER + 2 * I_G, (l + 2) * PER_LAYER, (M / 256) * (2 * DFF / 256));
        GSYNC();
        PH(11) { GEMM_PLAIN(HB, W_D2, DM, DFF, YB, YLD); if (REP_DN == 2) GEMM_PLAIN(HB, W_D2, DM, DFF, YB, YLD); }
        GSYNC();
        if (l + 1 < DEPTH) { PH(12) E_POST(INP(17) + l * DM, 0.5f, false); GSYNC(); }
        else { PH(12) E_POST(INP(17) + l * DM, 0.5f, true); }
    }
}

#undef ws
#undef xout
#undef XB
#undef HB
#undef PB
#undef OB
#undef RSX
#undef SSQ
#undef YB
#undef wl
#undef lane
#undef MYTID
#undef TI_DECODE
#undef CONV_RANGE
#undef CONV_TAIL
extern "C" void kernel_launch(void* const* d_in, const int* in_sizes, int n_in, void* d_out, int out_size, void* d_ws, size_t ws_size, hipStream_t stream) {
    static int grid = 0;
    if (grid == 0) {
        if (n_in != 21 || out_size != M * DM || ws_size < WS_END) { fprintf(stderr, "kernel_launch: unexpected shapes (n_in %d out %d ws %zu)\n", n_in, out_size, ws_size); grid = -1; return; }
        int dev = 0, cus = 0, per_cu = 0;
        hipGetDevice(&dev); hipDeviceGetAttribute(&cus, hipDeviceAttributeMultiprocessorCount, dev);
        hipFuncSetAttribute((const void*)mega_fwd, hipFuncAttributeMaxDynamicSharedMemorySize, LDS_BYTES);
        if (hipOccupancyMaxActiveBlocksPerMultiprocessor(&per_cu, (const void*)mega_fwd, NWAVES * 64, LDS_BYTES) != hipSuccess || per_cu < 1) per_cu = 1;
        (void)hipGetLastError();
        grid = cus * per_cu;
    }
    if (grid < 0) return;
    if (hipMemsetAsync((char*)d_ws + WS_CTL, 0, CTL_BYTES, stream) != hipSuccess) { fprintf(stderr, "kernel_launch: memset of the barrier words failed\n"); return; }
    Args a{};
    for (int i = 0; i < 21; ++i) a.in[i] = (const float*)d_in[i];
    a.out = (float*)d_out; a.ws = (unsigned char*)d_ws;
    void* kargs[] = {&a};
    hipError_t e = hipLaunchCooperativeKernel((const void*)mega_fwd, dim3(grid), dim3(NWAVES * 64), kargs, LDS_BYTES, stream);
    if (e != hipSuccess) fprintf(stderr, "cooperative launch failed: %s (grid %d)\n", hipGetErrorString(e), grid);
}
```
